# Optimizing an MI355X kernel written in HIP

```python
import jax, jax.numpy as jnp
from jax import lax
import numpy as np

D_MODEL = 1024
BATCH = 8
SEQ = 2048
DEPTH = 2

GRID_W = 64
MIX_WIDTH = D_MODEL
HG_WIDTH = MIX_WIDTH // 2
HG_HEAD_DIM = 128
HG_HEADS = HG_WIDTH // HG_HEAD_DIM
HG_CHUNK = 64
ATT_WIDTH = MIX_WIDTH - HG_WIDTH
ATT_HEAD_DIM = 64
ATT_HEADS = ATT_WIDTH // ATT_HEAD_DIM
ATT_KV_HEADS = 2
ATT_GROUP = ATT_HEADS // ATT_KV_HEADS
KV_WIDTH = ATT_KV_HEADS * ATT_HEAD_DIM
Q_BLOCK = 128
ROPE_THETA = 10000.0
D_FF = 4 * D_MODEL
N_MOD = 6
EPS = 1e-6
IN_SIZES = [HG_WIDTH] * 5 + [ATT_WIDTH, KV_WIDTH, KV_WIDTH]
IN_COLS = sum(IN_SIZES)
IN_SPLITS = [int(s) for s in np.cumsum(IN_SIZES)[:-1]]

kernel_name = 'hybrid_hgrn2_axial_gqa_encoder'

F32 = jnp.float32


def rms_norm(x, gain):
    xf = x.astype(F32)
    y = xf * lax.rsqrt(jnp.mean(xf * xf, axis=-1, keepdims=True) + EPS)
    return (y * gain.astype(F32)).astype(x.dtype)


def hgrn_lower_bounds(lb_logits):
    p = jnp.cumsum(jax.nn.softmax(lb_logits.astype(F32), axis=0), axis=0)
    return p - p[0:1]


def chunked_gated_recurrence(q, k, v, log_f):
    N, S, H, dk = q.shape
    dv = v.shape[-1]
    nc = S // HG_CHUNK

    def to_chunks(a):
        return a.reshape(N, nc, HG_CHUNK, H, a.shape[-1]).transpose(1, 0, 3, 2, 4)

    xs = (to_chunks(q), to_chunks(k), to_chunks(v), to_chunks(log_f))
    lower = jnp.tril(jnp.ones((HG_CHUNK, HG_CHUNK), dtype=bool))[:, :, None]

    def step(state, inp):
        qi, ki, vi, gi = inp
        b = jnp.cumsum(gi, axis=-2)
        b_last = b[..., -1:, :]
        o_inter = jnp.einsum('nhtd,nhde->nhte', qi * jnp.exp(b), state)
        diff = b[..., :, None, :] - b[..., None, :, :]
        decay = jnp.exp(jnp.where(lower, diff, -jnp.inf))
        scores = jnp.einsum('nhtd,nhsd,nhtsd->nhts', qi, ki, decay)
        o_intra = jnp.einsum('nhts,nhse->nhte', scores, vi)
        k_dec = ki * jnp.exp(b_last - b)
        new_state = state * jnp.exp(b_last)[..., 0, :, None] + jnp.einsum('nhsd,nhse->nhde', k_dec, vi)
        return new_state, o_inter + o_intra

    state0 = jnp.zeros((N, H, dk, dv), F32)
    _, o = lax.scan(step, state0, xs)
    return o.transpose(1, 0, 3, 2, 4).reshape(N, S, H, dv)


def hgrn2_group(q, f_fwd, f_bwd, i, g, lb, out_gain):
    B, S, _ = q.shape

    def heads(a):
        return a.astype(F32).reshape(B, S, HG_HEADS, HG_HEAD_DIM)

    qh = jax.nn.silu(heads(q))
    ih = heads(i)
    lbh = lb.reshape(HG_HEADS, HG_HEAD_DIM)

    def gates(fz):
        z = heads(fz)
        log_f = jnp.logaddexp(jnp.log(lbh), jnp.log1p(-lbh) + jax.nn.log_sigmoid(z))
        return log_f, (1.0 - lbh) * jax.nn.sigmoid(-z)

    lf_fw, k_fw = gates(f_fwd)
    lf_bw, k_bw = gates(f_bwd)
    flip = lambda a: a[:, ::-1]
    both = lambda a, b: jnp.concatenate([a, flip(b)], axis=0)
    o = chunked_gated_recurrence(both(qh, qh), both(k_fw, k_bw), both(ih, ih), both(lf_fw, lf_bw))
    o = o[:B] + flip(o[B:])
    o = rms_norm(o, out_gain) * jax.nn.silu(heads(g))
    return o.reshape(B, S, HG_WIDTH).astype(q.dtype)


def axial_angles(seq_len):
    rows = seq_len // GRID_W
    row = jnp.repeat(jnp.arange(rows, dtype=F32), GRID_W)
    col = jnp.tile(jnp.arange(GRID_W, dtype=F32), rows)
    half = ATT_HEAD_DIM // 2
    inv_freq = 1.0 / (ROPE_THETA ** (jnp.arange(0, half, 2, dtype=F32) / half))
    return row[:, None, None] * inv_freq, col[:, None, None] * inv_freq


def rotate(x, ang):
    x1, x2 = jnp.split(x, 2, axis=-1)
    cos, sin = jnp.cos(ang), jnp.sin(ang)
    return jnp.concatenate([x1 * cos - x2 * sin, x2 * cos + x1 * sin], axis=-1)


def apply_axial_rope(x, ang_row, ang_col):
    xr, xc = jnp.split(x.astype(F32), 2, axis=-1)
    return jnp.concatenate([rotate(xr, ang_row), rotate(xc, ang_col)], axis=-1).astype(x.dtype)


def gqa_axial_group(q, k, v, q_gain, k_gain, out_gain):
    B, S, _ = q.shape
    qh = rms_norm(q.reshape(B, S, ATT_HEADS, ATT_HEAD_DIM), q_gain)
    kh = rms_norm(k.reshape(B, S, ATT_KV_HEADS, ATT_HEAD_DIM), k_gain)
    vh = v.reshape(B, S, ATT_KV_HEADS, ATT_HEAD_DIM)
    ang_r, ang_c = axial_angles(S)
    qh = apply_axial_rope(qh, ang_r, ang_c)
    kh = apply_axial_rope(kh, ang_r, ang_c)
    scale = ATT_HEAD_DIM ** -0.5
    nb = S // Q_BLOCK
    qb = qh.reshape(B, nb, Q_BLOCK, ATT_KV_HEADS, ATT_GROUP, ATT_HEAD_DIM).transpose(1, 0, 3, 4, 2, 5)
    kt = kh.transpose(0, 2, 1, 3)
    vt = vh.transpose(0, 2, 1, 3)

    def block(qi):
        s = jnp.einsum('bkgqd,bksd->bkgqs', qi, kt).astype(F32) * scale
        p = jax.nn.softmax(s, axis=-1).astype(vt.dtype)
        return jnp.einsum('bkgqs,bksd->bkgqd', p, vt)

    o = lax.map(block, qb)
    o = o.transpose(1, 0, 4, 2, 3, 5).reshape(B, S, ATT_HEADS, ATT_HEAD_DIM)
    o = rms_norm(o, out_gain)
    return o.reshape(B, S, ATT_WIDTH)


def hybrid_layer(x, mod, lb, pre_mix, post_mix, w_in, w_out, hg_out_gain, q_gain, k_gain,
                 att_out_gain, pre_ff, post_ff, w_ff1, w_ff2):
    shift1, scale1, gate1, shift2, scale2, gate2 = [m[:, None, :] for m in jnp.split(mod, N_MOD, axis=-1)]
    h = rms_norm(x, pre_mix) * (1.0 + scale1) + shift1
    z = h @ w_in
    hq, hf_fw, hf_bw, hi, hg, aq, ak, av = jnp.split(z, IN_SPLITS, axis=-1)
    y_hgrn = hgrn2_group(hq, hf_fw, hf_bw, hi, hg, lb, hg_out_gain)
    y_att = gqa_axial_group(aq, ak, av, q_gain, k_gain, att_out_gain)
    y = jnp.concatenate([y_hgrn, y_att.astype(y_hgrn.dtype)], axis=-1) @ w_out
    x = x + gate1 * rms_norm(y, post_mix)
    h = rms_norm(x, pre_ff) * (1.0 + scale2) + shift2
    y = jnp.square(jax.nn.relu(h @ w_ff1)) @ w_ff2
    return x + gate2 * rms_norm(y, post_ff)


def setup_inputs(seed: int = 0) -> dict:
    key = jax.random.key(seed)
    ks = jax.random.split(key, 20)
    nrm = lambda k, shape, s: jax.random.normal(k, shape, F32) * s
    gain = lambda k, shape: 1.0 + 0.05 * jax.random.normal(k, shape, F32)
    return {
        'x': nrm(ks[0], (BATCH, SEQ, D_MODEL), 1.0),
        'c': nrm(ks[1], (BATCH, D_MODEL), 1.0),
        'w_ada': nrm(ks[2], (D_MODEL, N_MOD * D_MODEL), D_MODEL ** -0.5),
        'ada_layer_bias': nrm(ks[3], (DEPTH, N_MOD * D_MODEL), 0.1),
        'hg_lb_logits': nrm(ks[4], (DEPTH, HG_WIDTH), 1.0),
        'pre_mix': gain(ks[5], (DEPTH, D_MODEL)),
        'post_mix': gain(ks[6], (DEPTH, D_MODEL)),
        'w_in': nrm(ks[7], (DEPTH, D_MODEL, IN_COLS), D_MODEL ** -0.5),
        'w_out': nrm(ks[8], (DEPTH, MIX_WIDTH, D_MODEL), MIX_WIDTH ** -0.5),
        'hg_out_gain': gain(ks[9], (DEPTH, HG_HEAD_DIM)),
        'q_gain': gain(ks[10], (DEPTH, ATT_HEAD_DIM)),
        'k_gain': gain(ks[11], (DEPTH, ATT_HEAD_DIM)),
        'att_out_gain': gain(ks[12], (DEPTH, ATT_HEAD_DIM)),
        'pre_ff': gain(ks[13], (DEPTH, D_MODEL)),
        'post_ff': gain(ks[14], (DEPTH, D_MODEL)),
        'w_ff1': nrm(ks[15], (DEPTH, D_MODEL, D_FF), D_MODEL ** -0.5),
        'w_ff2': nrm(ks[16], (DEPTH, D_FF, D_MODEL), D_FF ** -0.5),
    }


def reference(x, c, w_ada, ada_layer_bias, hg_lb_logits, pre_mix, post_mix, w_in, w_out,
              hg_out_gain, q_gain, k_gain, att_out_gain, pre_ff, post_ff, w_ff1, w_ff2):
    lb_table = hgrn_lower_bounds(hg_lb_logits)
    cond = jax.nn.silu(c) @ w_ada
    for l in range(DEPTH):
        mod = cond + ada_layer_bias[l]
        x = hybrid_layer(x, mod, lb_table[l], pre_mix[l], post_mix[l], w_in[l], w_out[l],
                         hg_out_gain[l], q_gain[l], k_gain[l], att_out_gain[l],
                         pre_ff[l], post_ff[l], w_ff1[l], w_ff2[l])
    return x
```

```cpp
#include <hip/hip_runtime.h>
#include <hip/hip_cooperative_groups.h>
#include <cstdio>
#include <cstdint>
namespace cg = cooperative_groups;
namespace pg8 {
#define PG8_LAS __attribute__((address_space(3)))
typedef unsigned short bf16_t;
typedef short bf16x8 __attribute__((ext_vector_type(8)));
typedef float f32x4 __attribute__((ext_vector_type(4)));
typedef unsigned u32x4 __attribute__((ext_vector_type(4)));
constexpr int BM = 256, BK = 64, HALF = 128, HTB = HALF * BK * 2  , STAGE_BYTES = 8 * HTB, NXCD = 8, WGM = 8;

__host__ __device__ __forceinline__ int lds_byte(int r, int c) { const int st = (r >> 4) * 2 + (c >> 5), rr = r & 15, cc = c & 31, ob = rr * 64 + cc * 2; return st * 1024 + (ob ^ (((ob >> 9) & 1) << 5)); }
__host__ __device__ __forceinline__ void stage_rc(int b, int& R, int& C) { const int st = b / 1024, sb = b % 1024, swz = sb ^ (((sb >> 9) & 1) << 5); R = (st >> 1) * 16 + swz / 64; C = (st & 1) * 32 + (swz % 64) / 2; }
__host__ __device__ __forceinline__ int perm32(int rho) { const int n = rho >> 4, i = rho & 15; return 8 * (i >> 2) + 4 * n + (i & 3); }

struct Unit { int pm, pn; };
struct Gemm { const bf16_t* A; const bf16_t* Bt; int M, N, K; };

struct StaticOrder {
    int nM, nN, nwg, G, c;
    __host__ __device__ void init(int M, int N, int G_, int c_) { nM = M / BM; nN = N / BM; nwg = nM * nN; G = G_; c = c_; }
    __host__ __device__ bool next(int i, Unit& u) const {
        const long L = (long)i * G + c; if (L >= nwg) return false;
        int wgid = (int)L; { const int q = nwg / NXCD, r = nwg % NXCD, xcd = wgid % NXCD, off = wgid / NXCD; wgid = (xcd < r ? xcd * (q + 1) : r * (q + 1) + (xcd - r) * q) + off; }
        const int nig = WGM * nN, gid = wgid / nig, fm = gid * WGM, gsz = (nM - fm) < WGM ? (nM - fm) : WGM;
        u.pm = fm + ((wgid % nig) % gsz); u.pn = (wgid % nig) / gsz; return true;
    }
    __device__ __forceinline__ void a_ready(const Unit&) const {}
    __device__ __forceinline__ void done(const Unit&) const {}
};

typedef float f32x2_cv __attribute__((ext_vector_type(2)));
typedef __bf16 bf16x2_cv __attribute__((ext_vector_type(2)));
__device__ __forceinline__ unsigned cvt_pk_bf16(float lo, float hi) { const f32x2_cv v = {lo, hi}; const bf16x2_cv b = __builtin_convertvector(v, bf16x2_cv); return __builtin_bit_cast(unsigned, b); }
template <class Epi, class Sched, bool ALIGN_EPI = false, bool SP2 = false>
__device__ __forceinline__ void gemm_phase(PG8_LAS unsigned char* lds, const Gemm g, const Sched& S, const Epi& E) {
    int tid = threadIdx.x; asm volatile("" : "+v"(tid)); const int wid = __builtin_amdgcn_readfirstlane(tid >> 6), lane = tid & 63, wr = wid >> 2, wc = wid & 3, fr = lane & 15, fq = lane >> 4;
    const int K = g.K, nt = K / BK;
    unsigned voffA[2], voffB[2];
#pragma unroll
    for (int i = 0; i < 2; ++i) { int R, C; stage_rc(tid * 16 + i * 8192, R, C); const int Rb = Epi::PERM ? ((R & ~31) + perm32(R & 31)) : R;
        voffA[i] = (unsigned)(R * K + C) * 2u; voffB[i] = (unsigned)(Rb * K + C) * 2u; }
    const size_t kstep = (size_t)(BK * 2);
    const size_t hstep = (size_t)HALF * K * 2;
    const size_t tstep = 2 * hstep;
    const unsigned ldsw = (unsigned)wid * 1024u;
    const int aoff = lds_byte(wr * 64 + fr, fq * 8), boff = lds_byte(wc * 32 + fr, fq * 8);
#define PG8_SA(b, h) (((b) * 2 + (h)) * HTB)
#define PG8_SB(b, h) ((4 + (b) * 2 + (h)) * HTB)
#define PG8_STAGE(bufoff, gbase, voff) do { _Pragma("unroll") for (int _i = 0; _i < 2; ++_i) \
        __builtin_amdgcn_global_load_lds((const unsigned*)((const char*)(gbase) + (voff)[_i]), (PG8_LAS unsigned*)(lds + (bufoff) + ldsw + _i * 8192), 16, 0, 0); } while (0)
#define PG8_LDA(dst, b, h) do { _Pragma("unroll") for (int m = 0; m < 4; ++m) _Pragma("unroll") for (int k = 0; k < 2; ++k) dst[m][k] = *(const PG8_LAS bf16x8*)(lds + PG8_SA(b, h) + aoff + m * 2048 + k * 1024); } while (0)
#define PG8_LDB(dst, b, h) do { _Pragma("unroll") for (int n = 0; n < 2; ++n) _Pragma("unroll") for (int k = 0; k < 2; ++k) dst[n][k] = *(const PG8_LAS bf16x8*)(lds + PG8_SB(b, h) + boff + n * 2048 + k * 1024); } while (0)
#define PG8_MMA(ai, bj, At, Bt) do { __builtin_amdgcn_s_setprio(1); _Pragma("unroll") for (int m = 0; m < 4; ++m) _Pragma("unroll") for (int n = 0; n < 2; ++n) _Pragma("unroll") for (int k = 0; k < 2; ++k) \
        acc[ai][bj][m][n] = __builtin_amdgcn_mfma_f32_16x16x32_bf16(Bt[n][k], At[m][k], acc[ai][bj][m][n], 0, 0, 0); __builtin_amdgcn_s_setprio(0); } while (0)
#define PG8_WAIT_V(n) asm volatile("s_waitcnt vmcnt(" #n ")" ::: "memory")
#define PG8_WAIT_L(n) asm volatile("s_waitcnt lgkmcnt(" #n ")" ::: "memory")
#define PG8_BAR __builtin_amdgcn_s_barrier()
#define PG8_SCHED __builtin_amdgcn_sched_barrier(0)
    Unit cur, nxt; int ui = 0;
    if (!S.next(0, cur)) return;
    f32x4 acc[2][2][4][2];
#pragma unroll
    for (int a = 0; a < 2; ++a)
#pragma unroll
        for (int b = 0; b < 2; ++b)
#pragma unroll
            for (int m = 0; m < 4; ++m)
#pragma unroll
                for (int n = 0; n < 2; ++n) acc[a][b][m][n] = (f32x4){0.f, 0.f, 0.f, 0.f};
    bf16x8 At[4][2], B0[2][2], B1[2][2];
    const char* cA = (const char*)g.A + (size_t)cur.pm * tstep; const char* cB = (const char*)g.Bt + (size_t)cur.pn * tstep;
    S.a_ready(cur);
    if constexpr (SP2) {
        PG8_STAGE(PG8_SB(0, 0), cB, voffB); PG8_STAGE(PG8_SB(0, 1), cB + hstep, voffB); PG8_STAGE(PG8_SA(0, 0), cA, voffA); PG8_STAGE(PG8_SA(0, 1), cA + hstep, voffA);
        if (wr == 1) PG8_BAR;
        PG8_WAIT_V(2); PG8_BAR;
        PG8_STAGE(PG8_SB(1, 0), cB + kstep, voffB); PG8_STAGE(PG8_SA(1, 0), cA + kstep, voffA); PG8_STAGE(PG8_SB(1, 1), cB + hstep + kstep, voffB);
        PG8_WAIT_V(6); PG8_BAR;
    } else {
        PG8_STAGE(PG8_SB(0, 0), cB, voffB); PG8_STAGE(PG8_SA(0, 0), cA, voffA); PG8_STAGE(PG8_SB(0, 1), cB + hstep, voffB); PG8_STAGE(PG8_SA(0, 1), cA + hstep, voffA);
        if (wr == 1) PG8_BAR;
        PG8_WAIT_V(4); PG8_BAR;
        PG8_STAGE(PG8_SB(1, 0), cB + kstep, voffB); PG8_STAGE(PG8_SA(1, 0), cA + kstep, voffA); PG8_STAGE(PG8_SB(1, 1), cB + hstep + kstep, voffB);
        PG8_WAIT_V(6); PG8_BAR;
    }
    for (;;) {
        const bool has_next = S.next(ui + 1, nxt);
        const char* nA = has_next ? (const char*)g.A + (size_t)nxt.pm * tstep : cA; const char* nB = has_next ? (const char*)g.Bt + (size_t)nxt.pn * tstep : cB;
        for (int t = 0; t < nt; t += 2) {
            const bool last = (t == nt - 2);
            const char* a1 = cA + (size_t)(t + 1) * kstep;
            const char* a2 = last ? nA : cA + (size_t)(t + 2) * kstep; const char* b2 = last ? nB : cB + (size_t)(t + 2) * kstep;
            const char* a3 = a2 + kstep; const char* b3 = b2 + kstep;
            if (last && has_next) S.a_ready(nxt);
            if constexpr (SP2) {
            PG8_LDB(B0, 0, 0); PG8_LDB(B1, 0, 1); PG8_SCHED; PG8_LDA(At, 0, 0); PG8_STAGE(PG8_SA(1, 1), a1 + hstep, voffA);
            PG8_WAIT_V(8); PG8_WAIT_L(0); PG8_BAR; PG8_MMA(0, 0, At, B0); PG8_MMA(0, 1, At, B1); PG8_BAR; PG8_SCHED;
            PG8_LDA(At, 0, 1); PG8_STAGE(PG8_SB(0, 0), b2, voffB); PG8_STAGE(PG8_SB(0, 1), b2 + hstep, voffB); PG8_STAGE(PG8_SA(0, 0), a2, voffA);
            PG8_WAIT_V(8); PG8_WAIT_L(0); PG8_BAR; PG8_MMA(1, 0, At, B0); PG8_MMA(1, 1, At, B1); PG8_BAR; PG8_SCHED;
            PG8_LDB(B0, 1, 0); PG8_LDB(B1, 1, 1); PG8_SCHED; PG8_LDA(At, 1, 0); PG8_STAGE(PG8_SA(0, 1), a2 + hstep, voffA);
            PG8_WAIT_V(8); PG8_WAIT_L(0); PG8_BAR; PG8_MMA(0, 0, At, B0); PG8_MMA(0, 1, At, B1); PG8_BAR; PG8_SCHED;
            PG8_LDA(At, 1, 1); PG8_STAGE(PG8_SB(1, 0), b3, voffB); PG8_STAGE(PG8_SB(1, 1), b3 + hstep, voffB); PG8_STAGE(PG8_SA(1, 0), a3, voffA);
            PG8_WAIT_V(8); PG8_WAIT_L(0); PG8_BAR; PG8_MMA(1, 0, At, B0); PG8_MMA(1, 1, At, B1); PG8_BAR; PG8_SCHED;
            } else {
            PG8_LDB(B0, 0, 0); PG8_SCHED; PG8_LDA(At, 0, 0); PG8_STAGE(PG8_SA(1, 1), a1 + hstep, voffA);
            PG8_WAIT_L(8); PG8_BAR; PG8_WAIT_L(0); PG8_MMA(0, 0, At, B0); PG8_BAR; PG8_SCHED;
            PG8_LDB(B1, 0, 1); PG8_STAGE(PG8_SB(0, 0), b2, voffB);
            PG8_BAR; PG8_WAIT_L(0); PG8_MMA(0, 1, At, B1); PG8_BAR;
            PG8_LDA(At, 0, 1); PG8_STAGE(PG8_SA(0, 0), a2, voffA);
            PG8_BAR; PG8_WAIT_L(0); PG8_MMA(1, 0, At, B0); PG8_BAR; PG8_SCHED;
            PG8_STAGE(PG8_SB(0, 1), b2 + hstep, voffB);
            PG8_WAIT_V(6); PG8_BAR; PG8_MMA(1, 1, At, B1); PG8_BAR;
            PG8_LDB(B0, 1, 0); PG8_SCHED; PG8_LDA(At, 1, 0); PG8_STAGE(PG8_SA(0, 1), a2 + hstep, voffA);
            PG8_WAIT_L(8); PG8_BAR; PG8_WAIT_L(0); PG8_MMA(0, 0, At, B0); PG8_BAR; PG8_SCHED;
            PG8_LDB(B1, 1, 1); PG8_STAGE(PG8_SB(1, 0), b3, voffB);
            PG8_BAR; PG8_WAIT_L(0); PG8_MMA(0, 1, At, B1); PG8_BAR;
            PG8_LDA(At, 1, 1); PG8_STAGE(PG8_SA(1, 0), a3, voffA);
            PG8_BAR; PG8_WAIT_L(0); PG8_MMA(1, 0, At, B0); PG8_BAR; PG8_SCHED;
            PG8_STAGE(PG8_SB(1, 1), b3 + hstep, voffB);
            PG8_WAIT_V(6); PG8_BAR; PG8_MMA(1, 1, At, B1); PG8_BAR;
            }
        }
        if constexpr (ALIGN_EPI) { if (wr == 0) PG8_BAR; }
        if constexpr (!Epi::AFTER_DRAIN) { E(acc, cur, wr, wc, fr, fq); S.done(cur); }
        if (!has_next) break;
#pragma unroll
        for (int a = 0; a < 2; ++a)
#pragma unroll
            for (int b = 0; b < 2; ++b)
#pragma unroll
                for (int m = 0; m < 4; ++m)
#pragma unroll
                    for (int n = 0; n < 2; ++n) acc[a][b][m][n] = (f32x4){0.f, 0.f, 0.f, 0.f};
        cur = nxt; cA = nA; cB = nB; ++ui;
        if constexpr (ALIGN_EPI) { if (wr == 1) PG8_BAR; }
    }
    PG8_WAIT_V(0);
    if constexpr (!ALIGN_EPI) { if (wr == 0) PG8_BAR; }
    PG8_BAR;
    if constexpr (Epi::AFTER_DRAIN) { E.fused(acc, cur, wr, wc, fr, fq, lds, wid, lane); S.done(cur); }
#undef PG8_SA
#undef PG8_SB
#undef PG8_STAGE
#undef PG8_LDA
#undef PG8_LDB
#undef PG8_MMA
#undef PG8_WAIT_V
#undef PG8_WAIT_L
#undef PG8_BAR
#undef PG8_SCHED
}
}

#define LAS __attribute__((address_space(3)))
typedef pg8::bf16_t bf16_t;
typedef pg8::bf16x8 bf16x8;
typedef pg8::f32x4 f32x4;
typedef pg8::u32x4 u32x4;
typedef float f32x16 __attribute__((ext_vector_type(16)));
typedef unsigned u32x2 __attribute__((ext_vector_type(2)));

constexpr int D = 1024, NB = 8, SEQ = 2048, M = NB * SEQ, FF = 4096, INC = 3328, HGW = 512, NMOD6 = 6 * D;
constexpr float EPS = 1e-6f;
constexpr size_t MiB = 1u << 20;
constexpr size_t WS_CTL = 0, CTL_BYTES = 1 * MiB;
constexpr size_t CT_COND = 0, CT_ROWSS = 196608, CT_LBT = 458752;
constexpr size_t WS_WIN = 1 * MiB, WS_WOUT = 14 * MiB, WS_W1 = 18 * MiB, WS_W2 = 34 * MiB;
constexpr size_t WS_ABUF = 50 * MiB;
constexpr size_t WS_QH = 82 * MiB, WS_LF = 98 * MiB, WS_VH = 130 * MiB, WS_GH = 146 * MiB, WS_AQ = 162 * MiB, WS_AK = 178 * MiB, WS_VT = 182 * MiB;
constexpr size_t WS_ST = 186 * MiB, WS_G = 250 * MiB, WS_RSP = 251 * MiB, WS_END = 252 * MiB;
constexpr size_t WS_YRAW1 = 82 * MiB, WS_U = 82 * MiB, WS_YRAW2 = 210 * MiB;
constexpr int LDS_BYTES = 147456;

__device__ __forceinline__ float bf2f(unsigned short h) { return __uint_as_float(((unsigned)h) << 16); }
__device__ __forceinline__ float bflo(unsigned w) { return __uint_as_float(w << 16); }
__device__ __forceinline__ float bfhi(unsigned w) { return __uint_as_float(w & 0xffff0000u); }
__device__ __forceinline__ unsigned pk2(float lo, float hi) { return pg8::cvt_pk_bf16(lo, hi); }
__device__ __forceinline__ unsigned short f2bf(float f) { return (unsigned short)(pg8::cvt_pk_bf16(f, 0.f) & 0xffffu); }
__device__ __forceinline__ float wave_sum(float v) {
#pragma unroll
    for (int o = 1; o < 64; o <<= 1) v += __shfl_xor(v, o);
    return v;
}
__device__ __forceinline__ int otid() { int t = threadIdx.x; asm volatile("" : "+v"(t)); return t; }
__device__ __forceinline__ float fexp(float x) { return __builtin_amdgcn_exp2f(x * 1.4426950408889634f); }
__device__ __forceinline__ float siluf(float x) { return x * __builtin_amdgcn_rcpf(1.f + fexp(-x)); }

struct EpiIn {
    static constexpr bool PERM = true, AFTER_DRAIN = false;
    bf16_t *Qh, *LF, *Vh, *Gh, *AQ, *AK, *VT; const float* lbt;
    __device__ __forceinline__ void operator()(const f32x4 (&acc)[2][2][4][2], const pg8::Unit& u, int wr, int wc, int fr, int fq) const {
        const int row0 = u.pm * 256 + wr * 64 + fr;
        const int pn = u.pn, grp = pn >> 1;
#pragma unroll
        for (int bj = 0; bj < 2; ++bj) {
            const int colt = (pn & 1) * 256 + bj * 128 + wc * 32 + 8 * fq;
            if (pn == 12) {
                const int cc = wc * 32 + 8 * fq;
                if (bj == 0) {
#pragma unroll
                    for (int ai = 0; ai < 2; ++ai)
#pragma unroll
                        for (int m = 0; m < 4; ++m) { const int row = row0 + ai * 128 + m * 16; const f32x4 v0 = acc[ai][bj][m][0], v1 = acc[ai][bj][m][1];
                            u32x4 w; w.x = pk2(v0[0], v0[1]); w.y = pk2(v0[2], v0[3]); w.z = pk2(v1[0], v1[1]); w.w = pk2(v1[2], v1[3]);
                            *(u32x4*)(AK + (size_t)row * 128 + cc) = w; }
                } else {
                    const int kvh = cc >> 6, d0 = cc & 63;
#pragma unroll
                    for (int ai = 0; ai < 2; ++ai)
#pragma unroll
                        for (int m = 0; m < 4; ++m) { const int row = row0 + ai * 128 + m * 16; const int b = row >> 11, s = row & 2047;
                            bf16_t* vp = VT + ((size_t)((b * 2 + kvh) * 64 + d0)) * 2048 + s;
#pragma unroll
                            for (int n = 0; n < 2; ++n)
#pragma unroll
                                for (int i = 0; i < 4; ++i) vp[(size_t)(4 * n + i) * 2048] = f2bf(acc[ai][bj][m][n][i]); }
                }
                continue;
            }
            bf16_t* dst; int mode;
            if (grp == 0) { dst = Qh; mode = 1; } else if (grp == 1) { dst = LF; mode = 2; } else if (grp == 2) { dst = LF + (size_t)M * HGW; mode = 2; }
            else if (grp == 3) { dst = Vh; mode = 0; } else if (grp == 4) { dst = Gh; mode = 1; } else { dst = AQ; mode = 0; }
            f32x4 lb0 = {0.f, 0.f, 0.f, 0.f}, lb1 = {0.f, 0.f, 0.f, 0.f};
            if (mode == 2) { lb0 = *(const f32x4*)(lbt + colt); lb1 = *(const f32x4*)(lbt + colt + 4); }
#pragma unroll
            for (int ai = 0; ai < 2; ++ai)
#pragma unroll
                for (int m = 0; m < 4; ++m) { const int row = row0 + ai * 128 + m * 16; f32x4 v0 = acc[ai][bj][m][0], v1 = acc[ai][bj][m][1];
                    if (mode == 1) {
#pragma unroll
                        for (int i = 0; i < 4; ++i) { v0[i] = siluf(v0[i]); v1[i] = siluf(v1[i]); }
                    } else if (mode == 2) {
#pragma unroll
                        for (int i = 0; i < 4; ++i) {
                            { const float z = v0[i], lb = lb0[i]; const float ls = fminf(z, 0.f) - __logf(1.f + fexp(-fabsf(z))); v0[i] = lb > 0.f ? __logf(lb + (1.f - lb) * fexp(ls)) : ls; }
                            { const float z = v1[i], lb = lb1[i]; const float ls = fminf(z, 0.f) - __logf(1.f + fexp(-fabsf(z))); v1[i] = lb > 0.f ? __logf(lb + (1.f - lb) * fexp(ls)) : ls; }
                        }
                    }
                    u32x4 w; w.x = pk2(v0[0], v0[1]); w.y = pk2(v0[2], v0[3]); w.z = pk2(v1[0], v1[1]); w.w = pk2(v1[2], v1[3]);
                    *(u32x4*)(dst + (size_t)row * HGW + colt) = w; }
        }
    }
};
struct EpiRaw {
    static constexpr bool PERM = true, AFTER_DRAIN = false;
    bf16_t* Y; float* rowss;
    __device__ __forceinline__ void operator()(const f32x4 (&acc)[2][2][4][2], const pg8::Unit& u, int wr, int wc, int fr, int fq) const {
        const int row0 = u.pm * 256 + wr * 64 + fr, col0 = u.pn * 256 + wc * 32 + 8 * fq;
#pragma unroll
        for (int ai = 0; ai < 2; ++ai)
#pragma unroll
            for (int m = 0; m < 4; ++m) { const int row = row0 + ai * 128 + m * 16; float s = 0.f;
#pragma unroll
                for (int bj = 0; bj < 2; ++bj) { const f32x4 v0 = acc[ai][bj][m][0], v1 = acc[ai][bj][m][1];
                    s += (v0[0] * v0[0] + v0[1] * v0[1]) + (v0[2] * v0[2] + v0[3] * v0[3]) + (v1[0] * v1[0] + v1[1] * v1[1]) + (v1[2] * v1[2] + v1[3] * v1[3]);
                    u32x4 w; w.x = pk2(v0[0], v0[1]); w.y = pk2(v0[2], v0[3]); w.z = pk2(v1[0], v1[1]); w.w = pk2(v1[2], v1[3]);
                    *(u32x4*)(Y + (size_t)row * D + col0 + bj * 128) = w; }
                s += __shfl_xor(s, 16); s += __shfl_xor(s, 32);
                if (fq == 0) rowss[(size_t)row * 16 + u.pn * 4 + wc] = s; }
    }
};
struct EpiRelu2 {
    static constexpr bool PERM = true, AFTER_DRAIN = false;
    bf16_t* U;
    __device__ __forceinline__ void operator()(const f32x4 (&acc)[2][2][4][2], const pg8::Unit& u, int wr, int wc, int fr, int fq) const {
        const int row0 = u.pm * 256 + wr * 64 + fr, col0 = u.pn * 256 + wc * 32 + 8 * fq;
#pragma unroll
        for (int ai = 0; ai < 2; ++ai)
#pragma unroll
            for (int m = 0; m < 4; ++m) { const int row = row0 + ai * 128 + m * 16;
#pragma unroll
                for (int bj = 0; bj < 2; ++bj) { f32x4 v0 = acc[ai][bj][m][0], v1 = acc[ai][bj][m][1];
#pragma unroll
                    for (int i = 0; i < 4; ++i) { const float a = fmaxf(v0[i], 0.f), b = fmaxf(v1[i], 0.f); v0[i] = a * a; v1[i] = b * b; }
                    u32x4 w; w.x = pk2(v0[0], v0[1]); w.y = pk2(v0[2], v0[3]); w.z = pk2(v1[0], v1[1]); w.w = pk2(v1[2], v1[3]);
                    *(u32x4*)(U + (size_t)row * FF + col0 + bj * 128) = w; } }
    }
};

__device__ __forceinline__ void transpose_item(const float* W, int K, int N, bf16_t* WT, LAS float* scr, int item, int lane) {
    const int nblk = N / 32, kb = item / nblk, nb = item % nblk, k0 = 64 * kb, n0 = 32 * nb;
#pragma unroll 8
    for (int i = 0; i < 32; ++i) { const int kk = 2 * i + (lane >> 5); scr[kk * 33 + (lane & 31)] = W[(size_t)(k0 + kk) * N + n0 + (lane & 31)]; }
    asm volatile("s_waitcnt lgkmcnt(0)" ::: "memory");
    const int c = lane & 7;
#pragma unroll
    for (int j = 0; j < 4; ++j) { const int n = (lane >> 3) + 8 * j; const LAS float* s = scr + (8 * c) * 33 + n;
        u32x4 o; o.x = pk2(s[0 * 33], s[1 * 33]); o.y = pk2(s[2 * 33], s[3 * 33]); o.z = pk2(s[4 * 33], s[5 * 33]); o.w = pk2(s[6 * 33], s[7 * 33]);
        *(u32x4*)(WT + (size_t)(n0 + n) * K + k0 + 8 * c) = o; }
    asm volatile("s_waitcnt lgkmcnt(0)" ::: "memory");
}

struct Args {
    const float *x, *c, *w_ada, *ada_bias, *lb_logits, *pre_mix, *post_mix, *w_in, *w_out, *hg_gain, *q_gain, *k_gain, *ao_gain, *pre_ff, *post_ff, *w_ff1, *w_ff2;
    float* out; unsigned char* ws; int stop_at, stop_l;
};

template <bool DBG = false>
__device__ __forceinline__ void row_phase(const float* xin, float* xout, const bf16_t* yraw, const float* rowss, const float* post, const float* cond, const float* biasg  , int gidx,
                                          bf16_t* hout, const float* pre, const float* biash  , int shidx, int scidx) {
    const int tid = otid(), lane = tid & 63, wave = tid >> 6;
    const int gw = blockIdx.x * 8 + wave, NGW = gridDim.x * 8;
    const int RPW = (M + NGW - 1) / NGW, rbeg = gw * RPW, rend = (rbeg + RPW < M) ? (rbeg + RPW) : M;
    int bcur = -1;
    f32x4 Gm[4], Am[4], Bm[4];
    f32x4 xn[4]; u32x2 yn[4]; f32x4 pn[4];
#pragma unroll
    for (int j = 0; j < 4; ++j) { xn[j] = (f32x4){0.f, 0.f, 0.f, 0.f}; yn[j] = (u32x2){0u, 0u}; pn[j] = (f32x4){0.f, 0.f, 0.f, 0.f}; Gm[j] = Am[j] = Bm[j] = (f32x4){0.f, 0.f, 0.f, 0.f}; }
#define RP_LOAD(rr) do { _Pragma("unroll") for (int j = 0; j < 4; ++j) { xn[j] = *(const f32x4*)(xin + (size_t)(rr) * D + 256 * j + 4 * lane); \
        if (yraw) { yn[j] = *(const u32x2*)(yraw + (size_t)(rr) * D + 256 * j + 4 * lane); pn[j] = *(const f32x4*)(rowss + (size_t)(rr) * 16 + 4 * j); } } } while (0)
    if (rbeg < rend) RP_LOAD(rbeg);
#pragma unroll 1
    for (int r = rbeg; r < rend; ++r) {
        f32x4 xv[4]; u32x2 yw[4]; f32x4 pv[4];
#pragma unroll
        for (int j = 0; j < 4; ++j) { xv[j] = xn[j]; yw[j] = yn[j]; pv[j] = pn[j]; }
        if (r + 1 < rend) RP_LOAD(r + 1);
        const int b = r >> 11;
        if (b != bcur) { bcur = b;
#pragma unroll
            for (int j = 0; j < 4; ++j) { const int c = 256 * j + 4 * lane;
                if (yraw) { const f32x4 pg = *(const f32x4*)(post + c); const f32x4 gc = *(const f32x4*)(cond + (size_t)b * NMOD6 + gidx * D + c), gb = *(const f32x4*)(biasg + gidx * D + c);
                    Gm[j] = (gc + gb) * pg; }
                if (hout) { const f32x4 pg = *(const f32x4*)(pre + c);
                    const f32x4 sc = *(const f32x4*)(cond + (size_t)b * NMOD6 + scidx * D + c), sb = *(const f32x4*)(biash + scidx * D + c);
                    const f32x4 sh = *(const f32x4*)(cond + (size_t)b * NMOD6 + shidx * D + c), hb = *(const f32x4*)(biash + shidx * D + c);
                    Am[j] = pg * (sc + sb + 1.f); Bm[j] = sh + hb; } } }
        if (yraw) {
            float ssum = 0.f;
#pragma unroll
            for (int q = 0; q < 4; ++q) ssum += (pv[q][0] + pv[q][1]) + (pv[q][2] + pv[q][3]);
            const float rs = rsqrtf(ssum * (1.f / D) + EPS);
#pragma unroll
            for (int j = 0; j < 4; ++j) { const int c = 256 * j + 4 * lane;
                xv[j][0] += Gm[j][0] * (bflo(yw[j].x) * rs); xv[j][1] += Gm[j][1] * (bfhi(yw[j].x) * rs);
                xv[j][2] += Gm[j][2] * (bflo(yw[j].y) * rs); xv[j][3] += Gm[j][3] * (bfhi(yw[j].y) * rs);
                *(f32x4*)(xout + (size_t)r * D + c) = xv[j]; }
        }
        if (hout) {
            float s = 0.f;
#pragma unroll
            for (int j = 0; j < 4; ++j) s += (xv[j][0] * xv[j][0] + xv[j][1] * xv[j][1]) + (xv[j][2] * xv[j][2] + xv[j][3] * xv[j][3]);
            const float rs2 = rsqrtf(wave_sum(s) * (1.f / D) + EPS);
#pragma unroll
            for (int j = 0; j < 4; ++j) { const int c = 256 * j + 4 * lane;
                float h[4];
#pragma unroll
                for (int i = 0; i < 4; ++i) h[i] = xv[j][i] * rs2 * Am[j][i] + Bm[j][i];
                u32x2 w; w.x = pk2(h[0], h[1]); w.y = pk2(h[2], h[3]);
                *(u32x2*)(hout + (size_t)r * D + c) = w; }
        }
    }
#undef RP_LOAD
}

__device__ __forceinline__ void attn_prep(bf16_t* AQ, bf16_t* AK, const float* qg, const float* kg) {
    const int tid = otid(), lane = tid & 63, wave = tid >> 6;
    const int gw = blockIdx.x * 8 + wave, NGW = gridDim.x * 8;
    const float invf = __builtin_amdgcn_exp2f(-(float)(lane & 15) * (13.287712379549449f / 16.f));
    const float qgl = qg[lane], kgl = kg[lane];
    constexpr float QSCALE = 0.125f * 1.4426950408889634f;
    for (int r = gw; r < M; r += NGW) {
        const int s = r & 2047; const float pos = (float)((lane >> 5) ? (s & 63) : (s >> 6));
        const float ang = pos * invf; const float cs = __cosf(ang), sn = __sinf(ang);
#pragma unroll
        for (int h = 0; h < 10; ++h) {
            bf16_t* p = (h < 8) ? (AQ + (size_t)r * 512 + h * 64 + lane) : (AK + (size_t)r * 128 + (h - 8) * 64 + lane);
            const float x = bf2f(*p);
            const float rs = rsqrtf(wave_sum(x * x) * (1.f / 64.f) + EPS);
            const float y = x * rs * (h < 8 ? qgl : kgl);
            const float pr = __shfl_xor(y, 16);
            float o = (lane & 16) ? (y * cs + pr * sn) : (y * cs - pr * sn);
            if (h < 8) o *= QSCALE;
            *p = f2bf(o);
        }
    }
}

template <bool fixm>
__device__ __forceinline__ void attn_units(LAS unsigned char* lds, const bf16_t* QP, const bf16_t* KP, const bf16_t* VT, bf16_t* ymix, const float* og, bf16_t* UT, const float* G, const float sinit);
__device__ __forceinline__ void attn_phase(LAS unsigned char* lds, const bf16_t* QP, const bf16_t* KP, const bf16_t* VT, bf16_t* ymix, const float* og, bf16_t* UT, const float* G, const float* qg, const float* kg) {
    const int tid = otid(), wid = tid >> 6, lane = tid & 63, r32 = lane & 31, hi = lane >> 5;
    float mq = fabsf(qg[lane]), mk = fabsf(kg[lane]);
#pragma unroll
    for (int o = 1; o < 64; o <<= 1) { mq = fmaxf(mq, __shfl_xor(mq, o)); mk = fmaxf(mk, __shfl_xor(mk, o)); }
    const float B2 = 8.f * mq * mk * 1.4426950408889634f * 1.01f;
    const bool fixm0 = __builtin_amdgcn_readfirstlane((int)(B2 <= 40.f)) != 0;
    if (fixm0) attn_units<true>(lds, QP, KP, VT, ymix, og, UT, G, -B2); else attn_units<false>(lds, QP, KP, VT, ymix, og, UT, G, 0.f);
}
template <bool fixm>
__device__ __forceinline__ void attn_units(LAS unsigned char* lds, const bf16_t* QP, const bf16_t* KP, const bf16_t* VT, bf16_t* ymix, const float* og, bf16_t* UT, const float* G, const float sinit) {
    const int tid = otid(), wid = tid >> 6, lane = tid & 63, r32 = lane & 31, hi = lane >> 5;
    const int skey = tid >> 3, sch = tid & 7;
    const unsigned soff = skey * 144 + sch * 16;
    for (int unit = blockIdx.x; unit < 512; unit += gridDim.x) {
        const int b = unit >> 6, kvh = (unit >> 5) & 1, qb = unit & 31;
        const int head = kvh * 4 + (wid >> 1), tok0 = qb * 64 + (wid & 1) * 32;
        const bf16_t* qp = QP + (size_t)(b * 2048 + tok0 + r32) * 512 + head * 64 + 8 * hi;
        bf16x8 qf[4];
#pragma unroll
        for (int ks = 0; ks < 4; ++ks) qf[ks] = *(const bf16x8*)(qp + 16 * ks);
        const bf16_t* kg = KP + (size_t)(b * 2048 + skey) * 128 + kvh * 64 + 8 * sch;
        const bf16_t* vg = VT + ((size_t)((b * 2 + kvh) * 64 + skey)) * 2048 + 8 * sch;
        u32x4 kr = *(const u32x4*)kg, vr = *(const u32x4*)vg;
        *(LAS u32x4*)(lds + soff) = kr; *(LAS u32x4*)(lds + 18432 + soff) = vr;
        __syncthreads();
        f32x16 o0, o1;
#pragma unroll
        for (int i = 0; i < 16; ++i) { o0[i] = 0.f; o1[i] = 0.f; }
        float mrun = -INFINITY, lrun = 0.f;
        const int h2item = blockIdx.x * 512 + tid; const bool h2on = (unit == (int)blockIdx.x) && (h2item < 64 * 2048);
        bf16_t* hp = UT; const float* gp = G; float hS[8]; u32x4 huw = {0u, 0u, 0u, 0u}; f32x4 hg0 = {0.f, 0.f, 0.f, 0.f}, hg1 = {0.f, 0.f, 0.f, 0.f};
#pragma unroll
        for (int i = 0; i < 8; ++i) hS[i] = 0.f;
        if (h2on) { const int seq = h2item >> 11, rem = h2item & 2047, e = rem >> 4, d0 = (rem & 15) * 8;
            hp = UT + (((size_t)seq * 32) * 128 + e) * 128 + d0; gp = G + (size_t)seq * 32 * 128 + d0;
            huw = *(const u32x4*)hp; hg0 = *(const f32x4*)gp; hg1 = *(const f32x4*)(gp + 4); }
        for (int j = 0; j < 32; ++j) {
            if (j + 1 < 32) { kr = *(const u32x4*)(kg + (size_t)(j + 1) * 64 * 128); vr = *(const u32x4*)(vg + (j + 1) * 64); }
            const LAS unsigned char* kb = lds + (j & 1) * 9216; const LAS unsigned char* vb = lds + 18432 + (j & 1) * 9216;
            f32x16 s0, s1;
#pragma unroll
            for (int i = 0; i < 16; ++i) { s0[i] = sinit; s1[i] = sinit; }
#pragma unroll
            for (int ks = 0; ks < 4; ++ks) {
                const bf16x8 a0 = *(const LAS bf16x8*)(kb + r32 * 144 + (16 * ks + 8 * hi) * 2);
                const bf16x8 a1 = *(const LAS bf16x8*)(kb + (32 + r32) * 144 + (16 * ks + 8 * hi) * 2);
                s0 = __builtin_amdgcn_mfma_f32_32x32x16_bf16(a0, qf[ks], s0, 0, 0, 0);
                s1 = __builtin_amdgcn_mfma_f32_32x32x16_bf16(a1, qf[ks], s1, 0, 0, 0);
            }
            if (h2on) {
                u32x4 o; o.x = pk2(hS[0], hS[1]); o.y = pk2(hS[2], hS[3]); o.z = pk2(hS[4], hS[5]); o.w = pk2(hS[6], hS[7]);
                *(u32x4*)(hp + (size_t)j * 16384) = o;
                hS[0] = hg0[0] * hS[0] + bflo(huw.x); hS[1] = hg0[1] * hS[1] + bfhi(huw.x); hS[2] = hg0[2] * hS[2] + bflo(huw.y); hS[3] = hg0[3] * hS[3] + bfhi(huw.y);
                hS[4] = hg1[0] * hS[4] + bflo(huw.z); hS[5] = hg1[1] * hS[5] + bfhi(huw.z); hS[6] = hg1[2] * hS[6] + bflo(huw.w); hS[7] = hg1[3] * hS[7] + bfhi(huw.w);
                if (j + 1 < 32) { huw = *(const u32x4*)(hp + (size_t)(j + 1) * 16384); hg0 = *(const f32x4*)(gp + (j + 1) * 128); hg1 = *(const f32x4*)(gp + (j + 1) * 128 + 4); }
            }
            if (fixm) {
                float ps0 = 0.f, ps1 = 0.f;
#pragma unroll
                for (int i = 0; i < 16; ++i) { s0[i] = __builtin_amdgcn_exp2f(s0[i]); s1[i] = __builtin_amdgcn_exp2f(s1[i]); ps0 += s0[i]; ps1 += s1[i]; }
                lrun += ps0 + ps1;
            } else {
                float mx = fmaxf(s0[0], s1[0]);
#pragma unroll
                for (int i = 1; i < 16; ++i) mx = fmaxf(mx, fmaxf(s0[i], s1[i]));
                mx = fmaxf(mx, __shfl_xor(mx, 32));
                const float mnew = fmaxf(mrun, mx); const float alpha = __builtin_amdgcn_exp2f(mrun - mnew); mrun = mnew;
                float ps = 0.f;
#pragma unroll
                for (int i = 0; i < 16; ++i) { s0[i] = __builtin_amdgcn_exp2f(s0[i] - mnew); s1[i] = __builtin_amdgcn_exp2f(s1[i] - mnew); ps += s0[i] + s1[i]; }
                lrun = lrun * alpha + ps;
#pragma unroll
                for (int i = 0; i < 16; ++i) { o0[i] *= alpha; o1[i] *= alpha; }
            }
#pragma unroll
            for (int mb = 0; mb < 2; ++mb)
#pragma unroll
                for (int u = 0; u < 2; ++u) {
                    u32x4 pw;
                    if (mb == 0) { pw.x = pk2(s0[8 * u + 0], s0[8 * u + 1]); pw.y = pk2(s0[8 * u + 2], s0[8 * u + 3]); pw.z = pk2(s0[8 * u + 4], s0[8 * u + 5]); pw.w = pk2(s0[8 * u + 6], s0[8 * u + 7]); }
                    else         { pw.x = pk2(s1[8 * u + 0], s1[8 * u + 1]); pw.y = pk2(s1[8 * u + 2], s1[8 * u + 3]); pw.z = pk2(s1[8 * u + 4], s1[8 * u + 5]); pw.w = pk2(s1[8 * u + 6], s1[8 * u + 7]); }
                    const bf16x8 pb = __builtin_bit_cast(bf16x8, pw);
                    const int keybase = 32 * mb + 16 * u;
                    const u32x2 l0 = *(const LAS u32x2*)(vb + r32 * 144 + (keybase + 4 * hi) * 2), h0 = *(const LAS u32x2*)(vb + r32 * 144 + (keybase + 8 + 4 * hi) * 2);
                    const u32x2 l1 = *(const LAS u32x2*)(vb + (32 + r32) * 144 + (keybase + 4 * hi) * 2), h1 = *(const LAS u32x2*)(vb + (32 + r32) * 144 + (keybase + 8 + 4 * hi) * 2);
                    u32x4 a0w; a0w.x = l0.x; a0w.y = l0.y; a0w.z = h0.x; a0w.w = h0.y;
                    u32x4 a1w; a1w.x = l1.x; a1w.y = l1.y; a1w.z = h1.x; a1w.w = h1.y;
                    o0 = __builtin_amdgcn_mfma_f32_32x32x16_bf16(__builtin_bit_cast(bf16x8, a0w), pb, o0, 0, 0, 0);
                    o1 = __builtin_amdgcn_mfma_f32_32x32x16_bf16(__builtin_bit_cast(bf16x8, a1w), pb, o1, 0, 0, 0);
                }
            if (j + 1 < 32) { const unsigned nb = ((j + 1) & 1) * 9216; *(LAS u32x4*)(lds + nb + soff) = kr; *(LAS u32x4*)(lds + 18432 + nb + soff) = vr; }
            __syncthreads();
        }
        const float l = lrun + __shfl_xor(lrun, 32); const float inv = 1.f / l;
        float ss = 0.f;
#pragma unroll
        for (int i = 0; i < 16; ++i) { o0[i] *= inv; o1[i] *= inv; ss += o0[i] * o0[i] + o1[i] * o1[i]; }
        ss += __shfl_xor(ss, 32);
        const float rs = rsqrtf(ss * (1.f / 64.f) + EPS);
        bf16_t* yp = ymix + (size_t)(b * 2048 + tok0 + r32) * D + 512 + head * 64;
#pragma unroll
        for (int q4 = 0; q4 < 4; ++q4) {
            { const int d0 = 8 * q4 + 4 * hi; const f32x4 g = *(const f32x4*)(og + d0);
              u32x2 w; w.x = pk2(o0[4 * q4 + 0] * rs * g[0], o0[4 * q4 + 1] * rs * g[1]); w.y = pk2(o0[4 * q4 + 2] * rs * g[2], o0[4 * q4 + 3] * rs * g[3]); *(u32x2*)(yp + d0) = w; }
            { const int d0 = 32 + 8 * q4 + 4 * hi; const f32x4 g = *(const f32x4*)(og + d0);
              u32x2 w; w.x = pk2(o1[4 * q4 + 0] * rs * g[0], o1[4 * q4 + 1] * rs * g[1]); w.y = pk2(o1[4 * q4 + 2] * rs * g[2], o1[4 * q4 + 3] * rs * g[3]); *(u32x2*)(yp + d0) = w; }
        }
    }
}

__device__ __forceinline__ void h1_load(int unit, unsigned bo0, int I, const bf16_t* LF, const bf16_t* Vh, unsigned (&lw)[8], unsigned (&vw)[8]) {
    const int c = unit & 31, dir = (unit >> 5) & 1, h = (unit >> 6) & 3, n = unit >> 8;
    const bf16_t* lfb = LF + ((size_t)dir * M + (size_t)n * 2048) * HGW + h * 128; const bf16_t* vhb = Vh + (size_t)n * 2048 * HGW + h * 128;
#pragma unroll
    for (int j = 0; j < 8; ++j) {
        const int f0 = 64 * c + 16 * I + 2 * j, f1 = f0 + 1; const int t0 = dir ? (2047 - f0) : f0, t1 = dir ? (2047 - f1) : f1;
        const unsigned b0 = (unsigned)(t0 * (HGW * 2)) + bo0, b1 = (unsigned)(t1 * (HGW * 2)) + bo0;
        lw[j] = (unsigned)*(const bf16_t*)((const char*)lfb + b0) | ((unsigned)*(const bf16_t*)((const char*)lfb + b1) << 16);
        vw[j] = (unsigned)*(const bf16_t*)((const char*)vhb + b0) | ((unsigned)*(const bf16_t*)((const char*)vhb + b1) << 16); }
}
__device__ __forceinline__ void h1_phase(LAS unsigned char* lds, const bf16_t* LF, const bf16_t* Vh, bf16_t* UT, float* G) {
    const int tid = otid(), wid = tid >> 6, lane = tid & 63, fr = lane & 15, fq = lane >> 4;
    const int d = tid & 127, I = tid >> 7;
    LAS float* Ts = (LAS float*)lds; LAS unsigned char* kdT = lds + 2048; LAS unsigned char* vT = lds + 2048 + 18432;
    unsigned lwn[8], vwn[8];
#pragma unroll
    for (int j = 0; j < 8; ++j) { lwn[j] = 0u; vwn[j] = 0u; }
    if ((int)blockIdx.x < 2048) { unsigned bo0 = (unsigned)d * 2u; asm volatile("" : "+v"(bo0)); h1_load(blockIdx.x, bo0, I, LF, Vh, lwn, vwn); }
#pragma unroll 1
    for (int unit = blockIdx.x; unit < 2048; unit += gridDim.x) {
        unsigned lw[8], vw[8];
#pragma unroll
        for (int j = 0; j < 8; ++j) { lw[j] = lwn[j]; vw[j] = vwn[j]; }
        if (unit + (int)gridDim.x < 2048) { unsigned bo0 = (unsigned)d * 2u; asm volatile("" : "+v"(bo0)); h1_load(unit + gridDim.x, bo0, I, LF, Vh, lwn, vwn); }
        float beta[16], lf[16];
#pragma unroll
        for (int j = 0; j < 8; ++j) { lf[2 * j] = bflo(lw[j]); lf[2 * j + 1] = bfhi(lw[j]); }
        float run = 0.f;
#pragma unroll
        for (int j = 0; j < 16; ++j) { run += lf[j]; beta[j] = run; }
        Ts[I * 128 + d] = run;
        __syncthreads();
        const float T0 = Ts[d], T1 = Ts[128 + d], T2 = Ts[256 + d], T3 = Ts[384 + d];
        const float r4 = (T0 + T1) + (T2 + T3);
        const float rI = (I > 0 ? T0 : 0.f) + (I > 1 ? T1 : 0.f) + (I > 2 ? T2 : 0.f);
        const float base = r4 - rI;
        unsigned kw[8];
#pragma unroll
        for (int j = 0; j < 8; ++j) {
            const float k0 = (1.f - fexp(lf[2 * j])) * fexp(base - beta[2 * j]), k1 = (1.f - fexp(lf[2 * j + 1])) * fexp(base - beta[2 * j + 1]);
            kw[j] = pk2(k0, k1); }
        { u32x4 a; a.x = kw[0]; a.y = kw[1]; a.z = kw[2]; a.w = kw[3]; u32x4 bq; bq.x = kw[4]; bq.y = kw[5]; bq.z = kw[6]; bq.w = kw[7];
          *(LAS u32x4*)(kdT + d * 144 + I * 32) = a; *(LAS u32x4*)(kdT + d * 144 + I * 32 + 16) = bq; }
        { u32x4 a; a.x = vw[0]; a.y = vw[1]; a.z = vw[2]; a.w = vw[3]; u32x4 bq; bq.x = vw[4]; bq.y = vw[5]; bq.z = vw[6]; bq.w = vw[7];
          *(LAS u32x4*)(vT + d * 144 + I * 32) = a; *(LAS u32x4*)(vT + d * 144 + I * 32 + 16) = bq; }
        if (I == 0) G[(size_t)unit * 128 + d] = fexp(r4);
        __syncthreads();
        bf16x8 bfr[2];
#pragma unroll
        for (int ks = 0; ks < 2; ++ks) bfr[ks] = *(const LAS bf16x8*)(vT + (16 * wid + fr) * 144 + (32 * ks + 8 * fq) * 2);
        bf16_t* up = UT + ((size_t)unit * 128 + 16 * wid + fr) * 128 + 4 * fq;
#pragma unroll
        for (int mb = 0; mb < 8; ++mb) {
            f32x4 acc = {0.f, 0.f, 0.f, 0.f};
#pragma unroll
            for (int ks = 0; ks < 2; ++ks) { const bf16x8 a = *(const LAS bf16x8*)(kdT + (16 * mb + fr) * 144 + (32 * ks + 8 * fq) * 2);
                acc = __builtin_amdgcn_mfma_f32_16x16x32_bf16(a, bfr[ks], acc, 0, 0, 0); }
            u32x2 w; w.x = pk2(acc[0], acc[1]); w.y = pk2(acc[2], acc[3]);
            *(u32x2*)(up + 16 * mb) = w;
        }
        __syncthreads();
    }
}

__device__ __forceinline__ void h2_phase(bf16_t* UT, const float* G) {
    const int gt = blockIdx.x * 512 + otid(), GN = gridDim.x * 512;
    for (int item = gt + GN; item < 64 * 2048; item += GN) {
        const int seq = item >> 11, rem = item & 2047, e = rem >> 4, d0 = (rem & 15) * 8;
        float S[8];
#pragma unroll
        for (int i = 0; i < 8; ++i) S[i] = 0.f;
#pragma unroll 4
        for (int c = 0; c < 32; ++c) {
            const size_t unit = (size_t)seq * 32 + c;
            bf16_t* p = UT + (unit * 128 + e) * 128 + d0;
            const u32x4 uw = *(const u32x4*)p;
            const f32x4 g0 = *(const f32x4*)(G + unit * 128 + d0), g1 = *(const f32x4*)(G + unit * 128 + d0 + 4);
            u32x4 o; o.x = pk2(S[0], S[1]); o.y = pk2(S[2], S[3]); o.z = pk2(S[4], S[5]); o.w = pk2(S[6], S[7]);
            *(u32x4*)p = o;
            S[0] = g0[0] * S[0] + bflo(uw.x); S[1] = g0[1] * S[1] + bfhi(uw.x); S[2] = g0[2] * S[2] + bflo(uw.y); S[3] = g0[3] * S[3] + bfhi(uw.y);
            S[4] = g1[0] * S[4] + bflo(uw.z); S[5] = g1[1] * S[5] + bfhi(uw.z); S[6] = g1[2] * S[6] + bflo(uw.w); S[7] = g1[3] * S[7] + bfhi(uw.w);
        }
    }
}

constexpr int H3_TS = 0, H3_RED = 2048, H3_RSV = 4096, H3_QT = 4352, H3_QB = 21760, H3_KV = 39168, H3_VT = 82688, H3_P = 101120, H3_END = 110336;
__device__ __forceinline__ void h3_load(int unit, int dir, unsigned bo0, int I, const bf16_t* LF, const bf16_t* Qh, const bf16_t* Vh, unsigned (&lq)[16], unsigned (&vw)[8]) {
    const int c = unit & 31, h = (unit >> 5) & 3, n = unit >> 7;
    const size_t ub = ((size_t)n * 2048 + 64 * c) * HGW + h * 128;
    const bf16_t* lfb = LF + (size_t)dir * M * HGW + ub; const bf16_t* qhb = Qh + ub; const bf16_t* vhb = Vh + ub;
#pragma unroll
    for (int j = 0; j < 16; ++j) { const int t = 16 * I + j; const int p = dir ? (63 - t) : t; const unsigned bo = (unsigned)(p * (HGW * 2)) + bo0;
        lq[j] = (unsigned)*(const bf16_t*)((const char*)lfb + bo) | ((unsigned)*(const bf16_t*)((const char*)qhb + bo) << 16);
        const unsigned v = (unsigned)*(const bf16_t*)((const char*)vhb + bo);
        if (j & 1) vw[j >> 1] |= v << 16; else vw[j >> 1] = v; }
}
__device__ __forceinline__ void h3_phase(LAS unsigned char* lds, const bf16_t* LF, const bf16_t* Qh, const bf16_t* Vh, const bf16_t* Gh, const bf16_t* ST, const float* hgain, bf16_t* ymix) {
    const int tid = otid(), wid = tid >> 6, lane = tid & 63, fr = lane & 15, fq = lane >> 4;
    const int d = tid & 127, I = tid >> 7;
    LAS float* Ts = (LAS float*)(lds + H3_TS); LAS float* red = (LAS float*)(lds + H3_RED); LAS float* rsv = (LAS float*)(lds + H3_RSV);
    LAS unsigned char* qt = lds + H3_QT; LAS unsigned char* qbL = lds + H3_QB; LAS unsigned char* kv = lds + H3_KV; LAS unsigned char* vT = lds + H3_VT; LAS unsigned char* P = lds + H3_P;
    for (int i = tid; i < 9216 / 4; i += 512) ((LAS unsigned*)P)[i] = 0u;
    __syncthreads();
    int ndu = 0;
    for (int u = blockIdx.x; u < 1024; u += gridDim.x) ndu += 2;
    unsigned lqn[16], vwn[8];
#pragma unroll
    for (int j = 0; j < 16; ++j) lqn[j] = 0u;
#pragma unroll
    for (int j = 0; j < 8; ++j) vwn[j] = 0u;
    if (ndu > 0) { unsigned bo0 = (unsigned)d * 2u; asm volatile("" : "+v"(bo0)); h3_load(blockIdx.x, 0, bo0, I, LF, Qh, Vh, lqn, vwn); }
    f32x4 acc[4];
#pragma unroll
    for (int mb = 0; mb < 4; ++mb) acc[mb] = (f32x4){0.f, 0.f, 0.f, 0.f};
#pragma unroll 1
    for (int du = 0; du < ndu; ++du) {
        const int unit = blockIdx.x + (du >> 1) * gridDim.x, dir = du & 1;
        const int c = unit & 31, h = (unit >> 5) & 3, n = unit >> 7;
        unsigned lq[16], vw[8];
#pragma unroll
        for (int j = 0; j < 16; ++j) lq[j] = lqn[j];
#pragma unroll
        for (int j = 0; j < 8; ++j) vw[j] = vwn[j];
        if (du + 1 < ndu) { unsigned bo0 = (unsigned)d * 2u; asm volatile("" : "+v"(bo0)); h3_load(blockIdx.x + ((du + 1) >> 1) * gridDim.x, (du + 1) & 1, bo0, I, LF, Qh, Vh, lqn, vwn); }
        const int cs = dir ? (31 - c) : c; const size_t su = ((size_t)((n * 4 + h) * 2 + dir)) * 32 + cs;
        float beta[16];
        float run = 0.f;
#pragma unroll
        for (int j = 0; j < 16; ++j) { run += bflo(lq[j]); beta[j] = run; }
        Ts[I * 128 + d] = run;
        __syncthreads();
        const float T0 = Ts[d], T1 = Ts[128 + d], T2 = Ts[256 + d];
        const float rI = (I > 0 ? T0 : 0.f) + (I > 1 ? T1 : 0.f) + (I > 2 ? T2 : 0.f);
        const float TI = (I == 0) ? T0 : (I == 1) ? T1 : (I == 2) ? T2 : 0.f;
        const float TI1 = (I == 0) ? T1 : (I == 1) ? T2 : 0.f;
        const float TI2 = (I == 0) ? T2 : 0.f;
        const float e_rI = fexp(rI);
        const float E1 = fexp(TI), E2 = fexp(TI + TI1), E3 = fexp(TI + TI1 + TI2);
        const int vb0 = (I == 0) ? 0 : (I == 1) ? 16 : (I == 2) ? 48 : 96;
        const int vb1 = (I == 0) ? 16 : (I == 1) ? 48 : 96, vb2 = (I == 0) ? 48 : 96;
#pragma unroll
        for (int j = 0; j < 16; ++j) {
            const int t = 16 * I + j;
            const float eb = fexp(beta[j]); const float qe = bfhi(lq[j]) * eb;
            *(LAS unsigned short*)(qt + t * 272 + d * 2) = f2bf(qe);
            *(LAS unsigned short*)(qbL + t * 272 + d * 2) = f2bf(qe * e_rI);
            const float k = 1.f - fexp(bflo(lq[j]));
            const float kd = k * fexp(-beta[j]);
            *(LAS unsigned short*)(kv + (vb0 + t) * 272 + d * 2) = f2bf(kd);
            if (I < 3) *(LAS unsigned short*)(kv + (vb1 + t) * 272 + d * 2) = f2bf(kd * E1);
            if (I < 2) *(LAS unsigned short*)(kv + (vb2 + t) * 272 + d * 2) = f2bf(kd * E2);
            if (I < 1) *(LAS unsigned short*)(kv + (96 + t) * 272 + d * 2) = f2bf(kd * E3);
            __builtin_amdgcn_sched_barrier(0);
        }
        { u32x4 a; a.x = vw[0]; a.y = vw[1]; a.z = vw[2]; a.w = vw[3]; u32x4 bq; bq.x = vw[4]; bq.y = vw[5]; bq.z = vw[6]; bq.w = vw[7];
          *(LAS u32x4*)(vT + d * 144 + I * 32) = a; *(LAS u32x4*)(vT + d * 144 + I * 32 + 16) = bq; }
        __syncthreads();
        for (int blk = wid; blk < 10; blk += 8) {
            const int Ib = (blk < 1) ? 0 : (blk < 3) ? 1 : (blk < 6) ? 2 : 3;
            const int Jb = blk - ((Ib * (Ib + 1)) >> 1);
            const int vbI = (Ib == 0) ? 0 : (Ib == 1) ? 16 : (Ib == 2) ? 48 : 96;
            f32x4 sc = {0.f, 0.f, 0.f, 0.f};
#pragma unroll
            for (int ks = 0; ks < 4; ++ks) {
                const bf16x8 a = *(const LAS bf16x8*)(qt + (16 * Ib + fr) * 272 + (32 * ks + 8 * fq) * 2);
                const bf16x8 bb = *(const LAS bf16x8*)(kv + (vbI + 16 * Jb + fr) * 272 + (32 * ks + 8 * fq) * 2);
                sc = __builtin_amdgcn_mfma_f32_16x16x32_bf16(a, bb, sc, 0, 0, 0);
            }
#pragma unroll
            for (int j = 0; j < 4; ++j) { float v = sc[j]; if (Ib == Jb && fr > 4 * fq + j) v = 0.f;
                *(LAS unsigned short*)(P + (16 * Ib + 4 * fq + j) * 144 + (16 * Jb + fr) * 2) = f2bf(v); }
        }
        bf16x8 sfr[4];
#pragma unroll
        for (int ks = 0; ks < 4; ++ks) sfr[ks] = *(const bf16x8*)(ST + (su * 128 + 16 * wid + fr) * 128 + 32 * ks + 8 * fq);
        __syncthreads();
#pragma unroll
        for (int mb = 0; mb < 4; ++mb) {
            const int p = 16 * mb + fr; const int tr = dir ? (63 - p) : p;
#pragma unroll
            for (int ks = 0; ks < 4; ++ks) { const bf16x8 a = *(const LAS bf16x8*)(qbL + tr * 272 + (32 * ks + 8 * fq) * 2);
                acc[mb] = __builtin_amdgcn_mfma_f32_16x16x32_bf16(a, sfr[ks], acc[mb], 0, 0, 0); }
#pragma unroll
            for (int ks = 0; ks < 2; ++ks) { const bf16x8 a = *(const LAS bf16x8*)(P + tr * 144 + (32 * ks + 8 * fq) * 2);
                const bf16x8 bv = *(const LAS bf16x8*)(vT + (16 * wid + fr) * 144 + (32 * ks + 8 * fq) * 2);
                acc[mb] = __builtin_amdgcn_mfma_f32_16x16x32_bf16(a, bv, acc[mb], 0, 0, 0); }
            __builtin_amdgcn_sched_barrier(0);
        }
        __syncthreads();
        if (dir == 0) continue;
#pragma unroll
        for (int mb = 0; mb < 4; ++mb)
#pragma unroll
            for (int j = 0; j < 4; ++j) { float s = acc[mb][j] * acc[mb][j];
                s += __shfl_xor(s, 1); s += __shfl_xor(s, 2); s += __shfl_xor(s, 4); s += __shfl_xor(s, 8);
                if (fr == 0) red[wid * 64 + 16 * mb + 4 * fq + j] = s; }
        __syncthreads();
        if (tid < 64) { float t = 0.f;
#pragma unroll
            for (int w = 0; w < 8; ++w) t += red[w * 64 + tid];
            rsv[tid] = rsqrtf(t * (1.f / 128.f) + EPS); }
        __syncthreads();
        const int e = 16 * wid + fr; const float ge = hgain[e];
        unsigned eo = (unsigned)e * 2u; asm volatile("" : "+v"(eo));
        const bf16_t* ghb = Gh + ((size_t)n * 2048 + 64 * c) * HGW + h * 128; bf16_t* ymb = ymix + ((size_t)n * 2048 + 64 * c) * D + h * 128;
#pragma unroll
        for (int mb = 0; mb < 4; ++mb) {
#pragma unroll
            for (int j = 0; j < 4; ++j) { const int p = 16 * mb + 4 * fq + j;
                const float y = acc[mb][j] * rsv[p] * ge * bf2f(*(const bf16_t*)((const char*)ghb + ((unsigned)(p * (HGW * 2)) + eo)));
                *(bf16_t*)((char*)ymb + ((unsigned)(p * (D * 2)) + eo)) = f2bf(y); }
            acc[mb] = (f32x4){0.f, 0.f, 0.f, 0.f};
        }
    }
}

#ifdef DIAG
__device__ __forceinline__ void nan_check_bf16(const bf16_t* buf, size_t n, unsigned* flag) {
    const size_t gt = (size_t)blockIdx.x * 512 + otid(), GN = (size_t)gridDim.x * 512; unsigned bad = 0;
#pragma unroll 1
    for (size_t i = gt; i < n / 2; i += GN) { const unsigned w = ((const unsigned*)buf)[i]; if ((w & 0x7f80u) == 0x7f80u || (w & 0x7f800000u) == 0x7f800000u) bad = 1; }
    if (bad) atomicOr(flag, 1u);
}
__device__ __forceinline__ void nan_check_f32(const float* buf, size_t n, unsigned* flag) {
    const size_t gt = (size_t)blockIdx.x * 512 + otid(), GN = (size_t)gridDim.x * 512; unsigned bad = 0;
#pragma unroll 1
    for (size_t i = gt; i < n; i += GN) { const unsigned w = __float_as_uint(buf[i]); if ((w & 0x7f800000u) == 0x7f800000u) bad = 1; }
    if (bad) atomicOr(flag, 1u);
}
#define DCHK_BF(buf, n, slot) nan_check_bf16(buf, n, DIAGW + (slot))
#define DCHK_F(buf, n, slot) nan_check_f32(buf, n, DIAGW + (slot))
#else
#define DCHK_BF(buf, n, slot)
#define DCHK_F(buf, n, slot)
#endif

#ifndef STOP_AT
#define STOP_AT 0
#endif
__device__ __forceinline__ void dump_bf16(const bf16_t* buf, float* out) {
    const size_t gt = (size_t)blockIdx.x * 512 + otid(), GN = (size_t)gridDim.x * 512;
#pragma unroll 1
    for (size_t i = gt; i < (size_t)M * D; i += GN) {
#ifdef DUMP_NANFLAG
        const unsigned short w = buf[i]; out[i] = ((w & 0x7f80u) == 0x7f80u) ? 1000.f : 0.f;
#else
        out[i] = bf2f(buf[i]);
#endif
    }
}
#ifndef STOP_L
#define STOP_L 0
#endif
#define STOPK(k, buf) if (a.stop_at == (k) && l == a.stop_l) { dump_bf16(buf, a.out); return; }
#define XB_TMO      128
#define XB_XCNT(j)  (256  + 64 * (j))
#define XB_XSUB(j)  (1280 + 64 * (j))
#define XB_XGEN(j)  (2304 + 64 * (j))
#define XB_TOP      3328
#define XB_TOPGEN   3392
#define XCD_BAR_WORDS 3456
#define XB_SPIN_CAP (1u << 18)

__device__ __forceinline__ unsigned xb_ld(unsigned* p)              { return __hip_atomic_load(p, __ATOMIC_RELAXED, __HIP_MEMORY_SCOPE_AGENT); }
__device__ __forceinline__ unsigned xb_add(unsigned* p, unsigned v) { return __hip_atomic_fetch_add(p, v, __ATOMIC_RELAXED, __HIP_MEMORY_SCOPE_AGENT); }
__device__ __forceinline__ unsigned xb_xcc_id() { return (unsigned)__builtin_amdgcn_s_getreg((3 << 11) | 20) & 0xFu; }
#define XB_SPIN(cond, bar) do { unsigned _sp = 0; while (cond) { __builtin_amdgcn_s_sleep(1); \
    if ((++_sp & 255u) == 0u) { if (xb_ld(&(bar)[XB_TMO])) break; if (_sp > XB_SPIN_CAP) { atomicAdd(&(bar)[XB_TMO], 1u); break; } } } } while (0)

struct XcdBarrier {
    unsigned* bar; unsigned x;
    volatile LAS unsigned* st;
};

__device__ __forceinline__ XcdBarrier xcd_barrier_post(unsigned* bar, volatile LAS unsigned* st) {
    XcdBarrier b; b.bar = bar; b.x = xb_xcc_id(); b.st = st;
    if (threadIdx.x == 0) (void)xb_add(&bar[XB_XCNT(b.x)], 1u);
    return b;
}
__device__ __forceinline__ void xcd_barrier_complete(unsigned* bar, unsigned x, unsigned& nloc, unsigned& nx) {
    const unsigned G = gridDim.x * gridDim.y * gridDim.z;
    unsigned sum, cnt, mine, sp = 0u;
    for (;;) {
        sum = 0u; cnt = 0u; mine = 0u;
#pragma unroll
        for (unsigned j = 0; j < 16; ++j) { const unsigned c = xb_ld(&bar[XB_XCNT(j)]); sum += c; cnt += (c > 0u) ? 1u : 0u; mine = (j == x) ? c : mine; }
        if (sum == G) break;
        __builtin_amdgcn_s_sleep(1);
        if ((++sp & 255u) == 0u) { if (xb_ld(&bar[XB_TMO])) break; if (sp > XB_SPIN_CAP) { atomicAdd(&bar[XB_TMO], 1u); break; } }
    }
    nloc = mine > 0u ? mine : 1u; nx = cnt > 0u ? cnt : 1u;
}

__device__ __forceinline__ void xcd_barrier(const XcdBarrier& b) {
    asm volatile("s_waitcnt vmcnt(0)" ::: "memory");
    __syncthreads();
    if (threadIdx.x == 0) {
        unsigned* bar = b.bar;
        __builtin_amdgcn_s_waitcnt(0);
        unsigned nloc = b.st[0], nx = b.st[1];
        if (nloc == 0u) { xcd_barrier_complete(bar, b.x, nloc, nx); b.st[0] = nloc; b.st[1] = nx; }
        const unsigned old = xb_add(&bar[XB_XSUB(b.x)], 1u);
        const unsigned gen = old / nloc;
        if (old + 1u == (gen + 1u) * nloc) {
            __builtin_amdgcn_fence(__ATOMIC_RELEASE, "agent");
            asm volatile("s_waitcnt vmcnt(0)" ::: "memory");
            const unsigned og = xb_add(&bar[XB_TOP], 1u);
            const unsigned tg = og / nx;
            if (og + 1u == (tg + 1u) * nx) xb_add(&bar[XB_TOPGEN], 1u);
            else XB_SPIN(xb_ld(&bar[XB_TOPGEN]) == tg, bar);
            __builtin_amdgcn_fence(__ATOMIC_ACQUIRE, "agent");
            xb_add(&bar[XB_XGEN(b.x)], 1u);
            asm volatile("s_waitcnt vmcnt(0)" ::: "memory");
        } else {
            XB_SPIN(xb_ld(&bar[XB_XGEN(b.x)]) == gen, bar);
            __builtin_amdgcn_fence(__ATOMIC_ACQUIRE, "agent");
            asm volatile("s_waitcnt vmcnt(0)" ::: "memory");
        }
    }
    __syncthreads();
}

__global__ void __launch_bounds__(512, 2) hybrid_fwd(Args a) {
    extern __shared__ __attribute__((aligned(16))) unsigned char lds_raw[];
    LAS unsigned char* lds = (LAS unsigned char*)lds_raw;
    cg::grid_group grid = cg::this_grid();
    { volatile LAS unsigned* st0 = (volatile LAS unsigned*)(lds + 140000); if (threadIdx.x < 2) st0[threadIdx.x] = 0u; __syncthreads(); }
    const XcdBarrier xbar = xcd_barrier_post((unsigned*)(a.ws + WS_CTL + 524288), (volatile LAS unsigned*)(lds + 140000));
#define GSYNC() xcd_barrier(xbar)
    unsigned char* ws = a.ws;
    float* COND = (float*)(ws + WS_CTL + CT_COND); float* ROWSS = (float*)(ws + WS_RSP); float* LBT = (float*)(ws + WS_CTL + CT_LBT);
    bf16_t* WINT = (bf16_t*)(ws + WS_WIN); bf16_t* WOUTT = (bf16_t*)(ws + WS_WOUT); bf16_t* W1T = (bf16_t*)(ws + WS_W1); bf16_t* W2T = (bf16_t*)(ws + WS_W2);
    bf16_t* ABUF = (bf16_t*)(ws + WS_ABUF);
    bf16_t* QH = (bf16_t*)(ws + WS_QH); bf16_t* LF = (bf16_t*)(ws + WS_LF); bf16_t* VH = (bf16_t*)(ws + WS_VH); bf16_t* GH = (bf16_t*)(ws + WS_GH);
    bf16_t* AQ = (bf16_t*)(ws + WS_AQ); bf16_t* AK = (bf16_t*)(ws + WS_AK); bf16_t* VT = (bf16_t*)(ws + WS_VT);
    bf16_t* ST = (bf16_t*)(ws + WS_ST); float* GG = (float*)(ws + WS_G);
    unsigned* DIAGW = (unsigned*)(ws + WS_CTL + 500000); (void)DIAGW;
    bf16_t* YRAW1 = (bf16_t*)(ws + WS_YRAW1); bf16_t* UB = (bf16_t*)(ws + WS_U); bf16_t* YRAW2 = (bf16_t*)(ws + WS_YRAW2);

    {
        const int tid = otid(), lane = tid & 63, wave = tid >> 6;
        LAS float* sc = (LAS float*)lds;
        LAS float* part = (LAS float*)(lds + 32768);
        if ((int)blockIdx.x < 192) {
            for (int i = tid; i < 8 * D; i += 512) sc[i] = siluf(a.c[i]);
            __syncthreads();
        }
        for (int ib = blockIdx.x; ib < 192; ib += gridDim.x) {
            const int col = tid & 31, kg = tid >> 5, j = ib * 32 + col;
            float ac[8];
#pragma unroll
            for (int b = 0; b < 8; ++b) ac[b] = 0.f;
#pragma unroll 8
            for (int kk = 0; kk < 64; ++kk) { const int k = kg * 64 + kk; const float w = a.w_ada[(size_t)k * NMOD6 + j];
#pragma unroll
                for (int b = 0; b < 8; ++b) ac[b] += sc[b * D + k] * w; }
#pragma unroll
            for (int b = 0; b < 8; ++b) part[(kg * 8 + b) * 32 + col] = ac[b];
            __syncthreads();
            if (tid < 256) { const int b = tid >> 5; float t = 0.f;
#pragma unroll
                for (int g = 0; g < 16; ++g) t += part[(g * 8 + b) * 32 + col];
                COND[b * NMOD6 + ib * 32 + col] = t; }
            __syncthreads();
        }
        if (blockIdx.x == gridDim.x - 1) { const float l0 = a.lb_logits[tid], l1 = a.lb_logits[HGW + tid]; LBT[tid] = 0.f; LBT[HGW + tid] = 1.f / (1.f + __expf(l0 - l1)); }
        LAS float* scr = (LAS float*)(lds + 49152 + wave * 8448);
        const int gw = blockIdx.x * 8 + wave, NGW = gridDim.x * 8;
        constexpr int I_IN = (D / 64) * (INC / 32), I_OUT = (D / 64) * (D / 32), I_1 = (D / 64) * (FF / 32), I_2 = (FF / 64) * (D / 32), I_L = I_IN + I_OUT + I_1 + I_2;
        for (int it = gw; it < 2 * I_L; it += NGW) {
            const int l = it / I_L; int r = it % I_L;
            if (r < I_IN) { transpose_item(a.w_in + (size_t)l * D * INC, D, INC, WINT + (size_t)l * INC * D, scr, r, lane); continue; } r -= I_IN;
            if (r < I_OUT) { transpose_item(a.w_out + (size_t)l * D * D, D, D, WOUTT + (size_t)l * D * D, scr, r, lane); continue; } r -= I_OUT;
            if (r < I_1) { transpose_item(a.w_ff1 + (size_t)l * D * FF, D, FF, W1T + (size_t)l * FF * D, scr, r, lane); continue; } r -= I_1;
            transpose_item(a.w_ff2 + (size_t)l * FF * D, FF, D, W2T + (size_t)l * D * FF, scr, r, lane);
        }
    }
    grid.sync();

    row_phase(a.x, nullptr, nullptr, nullptr, nullptr, COND, nullptr, 0, ABUF, a.pre_mix, a.ada_bias, 0, 1);
    GSYNC();
    { const int l = 0; STOPK(1, ABUF) }
    DCHK_BF(ABUF, (size_t)M * D, 0); DCHK_BF(WINT, (size_t)2 * INC * D, 1); DCHK_BF(W1T, (size_t)2 * FF * D, 1); DCHK_BF(W2T, (size_t)2 * FF * D, 1); DCHK_BF(WOUTT, (size_t)2 * D * D, 1);
#pragma unroll 1
    for (int l = 0; l < 2; ++l) {
        const float* biasl = a.ada_bias + (size_t)l * NMOD6;
        STOPK(11, ABUF)
        { pg8::Gemm g{ABUF, WINT + (size_t)l * INC * D, M, INC, D}; pg8::StaticOrder S; S.init(M, INC, (int)gridDim.x, (int)blockIdx.x);
          EpiIn E{QH, LF, VH, GH, AQ, AK, VT, LBT + l * HGW};
#ifndef SKIP_G1
#ifdef REP_GEMM
          pg8::gemm_phase<EpiIn, pg8::StaticOrder, true, true>(lds, g, S, E);
#endif
          pg8::gemm_phase<EpiIn, pg8::StaticOrder, true, true>(lds, g, S, E);
#endif
        }
        GSYNC();
        STOPK(2, LF) STOPK(12, QH) STOPK(13, AQ)
        DCHK_BF(QH, (size_t)M * HGW, 2 + 16 * l); DCHK_BF(LF, (size_t)2 * M * HGW, 3 + 16 * l); DCHK_BF(VH, (size_t)M * HGW, 4 + 16 * l); DCHK_BF(GH, (size_t)M * HGW, 4 + 16 * l); DCHK_BF(AQ, (size_t)M * HGW, 5 + 16 * l); DCHK_BF(AK, (size_t)M * 128, 5 + 16 * l); DCHK_BF(VT, (size_t)M * 128, 5 + 16 * l);
#ifdef REP_MIX
        attn_prep(AQ, AK, a.q_gain + l * 64, a.k_gain + l * 64);
#pragma unroll 1
        for (int rep = 0; rep < 2; ++rep) {
#define SKIP_PREP
#endif
#ifndef SKIP_H1
        h1_phase(lds, LF, VH, ST, GG);
#endif
#ifndef SKIP_PREP
        attn_prep(AQ, AK, a.q_gain + l * 64, a.k_gain + l * 64);
#endif
        GSYNC();
        STOPK(3, ST) STOPK(14, AQ)
        DCHK_BF(ST, (size_t)2048 * 128 * 128, 6 + 16 * l); DCHK_F(GG, (size_t)2048 * 128, 6 + 16 * l); DCHK_BF(AQ, (size_t)M * HGW, 7 + 16 * l); DCHK_BF(AK, (size_t)M * 128, 7 + 16 * l);
#ifndef SKIP_H2
        h2_phase(ST, GG);
#endif
#ifndef SKIP_ATT
        attn_phase(lds, AQ, AK, VT, ABUF, a.ao_gain + l * 64, ST, GG, a.q_gain + l * 64, a.k_gain + l * 64);
#endif
#ifdef REP_ATT
        attn_phase(lds, AQ, AK, VT, ABUF, a.ao_gain + l * 64, ST, GG, a.q_gain + l * 64, a.k_gain + l * 64);
#endif
        GSYNC();
        STOPK(4, ST) STOPK(15, ABUF)
        DCHK_BF(ST, (size_t)2048 * 128 * 128, 8 + 16 * l); DCHK_BF(ABUF, (size_t)M * D, 9 + 16 * l);
#ifndef SKIP_H3
        h3_phase(lds, LF, QH, VH, GH, ST, a.hg_gain + l * 128, ABUF);
#endif
        GSYNC();
        STOPK(5, ABUF)
        DCHK_BF(ABUF, (size_t)M * D, 10 + 16 * l);
#ifdef REP_MIX
        }
#endif
        { pg8::Gemm g{ABUF, WOUTT + (size_t)l * D * D, M, D, D}; pg8::StaticOrder S; S.init(M, D, (int)gridDim.x, (int)blockIdx.x);
          EpiRaw E{YRAW1, ROWSS};
#ifndef SKIP_G2
#ifdef REP_GEMM
          pg8::gemm_phase<EpiRaw, pg8::StaticOrder, true, true>(lds, g, S, E);
#endif
          pg8::gemm_phase<EpiRaw, pg8::StaticOrder, true, true>(lds, g, S, E);
#endif
        }
        GSYNC();
        STOPK(6, YRAW1)
        DCHK_BF(YRAW1, (size_t)M * D, 11 + 16 * l);
        row_phase(l == 0 ? a.x : a.out, a.out, YRAW1, ROWSS, a.post_mix + l * D, COND, biasl, 2, ABUF, a.pre_ff + l * D, biasl, 3, 4);
        GSYNC();
        if (a.stop_at == 7 && l == a.stop_l) return;
        DCHK_F(a.out, (size_t)M * D, 12 + 16 * l); DCHK_BF(ABUF, (size_t)M * D, 12 + 16 * l);
        { pg8::Gemm g{ABUF, W1T + (size_t)l * FF * D, M, FF, D}; pg8::StaticOrder S; S.init(M, FF, (int)gridDim.x, (int)blockIdx.x);
          EpiRelu2 E{UB};
#ifndef SKIP_G3
#ifdef REP_GEMM
          pg8::gemm_phase<EpiRelu2, pg8::StaticOrder, true, true>(lds, g, S, E);
#endif
          pg8::gemm_phase<EpiRelu2, pg8::StaticOrder, true, true>(lds, g, S, E);
#endif
        }
        GSYNC();
        STOPK(8, UB)
        DCHK_BF(UB, (size_t)M * FF, 13 + 16 * l);
        { pg8::Gemm g{UB, W2T + (size_t)l * D * FF, M, D, FF}; pg8::StaticOrder S; S.init(M, D, (int)gridDim.x, (int)blockIdx.x);
          EpiRaw E{YRAW2, ROWSS};
#ifndef SKIP_G4
#ifdef REP_GEMM
          pg8::gemm_phase<EpiRaw, pg8::StaticOrder, true, true>(lds, g, S, E);
#endif
          pg8::gemm_phase<EpiRaw, pg8::StaticOrder, true, true>(lds, g, S, E);
#endif
        }
        GSYNC();
        STOPK(9, YRAW2)
        DCHK_BF(YRAW2, (size_t)M * D, 14 + 16 * l);
#ifdef HDEBUG
        row_phase<true>
#else
        row_phase<false>
#endif
            (a.out, a.out, YRAW2, ROWSS, a.post_ff + l * D, COND, biasl, 5, l == 0 ? ABUF : nullptr, a.pre_mix + D, a.ada_bias + NMOD6, 0, 1);
        if (a.stop_at == 10 && l == a.stop_l) return;
        if (l == 0) GSYNC();
    }
#ifdef DIAG
    GSYNC();
    DCHK_F(a.out, (size_t)M * D, 31);
    GSYNC();
    { int first = -1; for (int k = 0; k < 32; ++k) if (first < 0 && DIAGW[k]) first = k;
      if (first >= 0) { const size_t gt = (size_t)blockIdx.x * 512 + otid(), GN = (size_t)gridDim.x * 512;
          for (size_t i = gt; i < (size_t)M * D; i += GN) a.out[i] = (i == 0) ? 1000.f * (float)(first + 1) : 0.f; } }
#endif
}

extern "C" void kernel_launch(void* const* d_in, const int* in_sizes, int n_in, void* d_out, int out_size, void* d_ws, size_t ws_size, hipStream_t stream) {
    static int grid = 0;
    if (grid == 0) {
        if (n_in != 17 || in_sizes[0] != M * D || out_size != M * D || ws_size < WS_END) { fprintf(stderr, "kernel_launch: unexpected shapes (n_in %d, in0 %d, out %d, ws %zu)\n", n_in, n_in > 0 ? in_sizes[0] : -1, out_size, ws_size); grid = -1; return; }
        int dev = 0, cus = 0, per_cu = 0;
        if (hipGetDevice(&dev) != hipSuccess || hipDeviceGetAttribute(&cus, hipDeviceAttributeMultiprocessorCount, dev) != hipSuccess) { grid = -1; return; }
        if (hipFuncSetAttribute((const void*)hybrid_fwd, hipFuncAttributeMaxDynamicSharedMemorySize, LDS_BYTES) != hipSuccess) { fprintf(stderr, "hipFuncSetAttribute failed\n"); grid = -1; return; }
        if (hipOccupancyMaxActiveBlocksPerMultiprocessor(&per_cu, (const void*)hybrid_fwd, 512, LDS_BYTES) != hipSuccess || per_cu < 1) { fprintf(stderr, "occupancy query: %d\n", per_cu); (void)hipGetLastError(); per_cu = 1; }
        grid = cus * 1;
    }
    if (grid < 0) return;
    if (hipMemsetAsync((char*)d_ws + WS_CTL + 524288, 0, 16384, stream) != hipSuccess) { fprintf(stderr, "memset failed\n"); return; }
    Args a{};
    a.x = (const float*)d_in[0]; a.c = (const float*)d_in[1]; a.w_ada = (const float*)d_in[2]; a.ada_bias = (const float*)d_in[3]; a.lb_logits = (const float*)d_in[4];
    a.pre_mix = (const float*)d_in[5]; a.post_mix = (const float*)d_in[6]; a.w_in = (const float*)d_in[7]; a.w_out = (const float*)d_in[8]; a.hg_gain = (const float*)d_in[9];
    a.q_gain = (const float*)d_in[10]; a.k_gain = (const float*)d_in[11]; a.ao_gain = (const float*)d_in[12]; a.pre_ff = (const float*)d_in[13]; a.post_ff = (const float*)d_in[14];
    a.w_ff1 = (const float*)d_in[15]; a.w_ff2 = (const float*)d_in[16];
    a.out = (float*)d_out; a.ws = (unsigned char*)d_ws; a.stop_at = STOP_AT; a.stop_l = STOP_L;
    void* args[] = {&a};
    hipError_t e = hipLaunchCooperativeKernel((const void*)hybrid_fwd, dim3(grid), dim3(512), args, LDS_BYTES, stream);
    if (e != hipSuccess) fprintf(stderr, "cooperative launch failed: %s (grid %d)\n", hipGetErrorString(e), grid);
}
```

```cpp
#include <hip/hip_runtime.h>
#include <hip/hip_cooperative_groups.h>
#include <cstdio>
#include <cstdint>
namespace cg = cooperative_groups;
namespace pg8 {
#define PG8_LAS __attribute__((address_space(3)))
typedef unsigned short bf16_t;
typedef short bf16x8 __attribute__((ext_vector_type(8)));
typedef float f32x4 __attribute__((ext_vector_type(4)));
typedef unsigned u32x4 __attribute__((ext_vector_type(4)));
constexpr int BM = 256, BK = 64, HALF = 128, HTB = HALF * BK * 2  , STAGE_BYTES = 8 * HTB, NXCD = 8, WGM = 8;

__host__ __device__ __forceinline__ int lds_byte(int r, int c) { const int st = (r >> 4) * 2 + (c >> 5), rr = r & 15, cc = c & 31, ob = rr * 64 + cc * 2; return st * 1024 + (ob ^ (((ob >> 9) & 1) << 5)); }
__host__ __device__ __forceinline__ void stage_rc(int b, int& R, int& C) { const int st = b / 1024, sb = b % 1024, swz = sb ^ (((sb >> 9) & 1) << 5); R = (st >> 1) * 16 + swz / 64; C = (st & 1) * 32 + (swz % 64) / 2; }
__host__ __device__ __forceinline__ int perm32(int rho) { const int n = rho >> 4, i = rho & 15; return 8 * (i >> 2) + 4 * n + (i & 3); }

struct Unit { int pm, pn; };
struct Gemm { const bf16_t* A; const bf16_t* Bt; int M, N, K; };

struct StaticOrder {
    int nM, nN, nwg, G, c;
    __host__ __device__ void init(int M, int N, int G_, int c_) { nM = M / BM; nN = N / BM; nwg = nM * nN; G = G_; c = c_; }
    __host__ __device__ bool next(int i, Unit& u) const {
        const long L = (long)i * G + c; if (L >= nwg) return false;
        int wgid = (int)L; { const int q = nwg / NXCD, r = nwg % NXCD, xcd = wgid % NXCD, off = wgid / NXCD; wgid = (xcd < r ? xcd * (q + 1) : r * (q + 1) + (xcd - r) * q) + off; }
        const int nig = WGM * nN, gid = wgid / nig, fm = gid * WGM, gsz = (nM - fm) < WGM ? (nM - fm) : WGM;
        u.pm = fm + ((wgid % nig) % gsz); u.pn = (wgid % nig) / gsz; return true;
    }
    __device__ __forceinline__ void a_ready(const Unit&) const {}
    __device__ __forceinline__ void done(const Unit&) const {}
};

typedef float f32x2_cv __attribute__((ext_vector_type(2)));
typedef __bf16 bf16x2_cv __attribute__((ext_vector_type(2)));
__device__ __forceinline__ unsigned cvt_pk_bf16(float lo, float hi) { const f32x2_cv v = {lo, hi}; const bf16x2_cv b = __builtin_convertvector(v, bf16x2_cv); return __builtin_bit_cast(unsigned, b); }
template <class Epi, class Sched, bool ALIGN_EPI = false, bool SP2 = false>
__device__ __forceinline__ void gemm_phase(PG8_LAS unsigned char* lds, const Gemm g, const Sched& S, const Epi& E) {
    int tid = threadIdx.x; asm volatile("" : "+v"(tid)); const int wid = __builtin_amdgcn_readfirstlane(tid >> 6), lane = tid & 63, wr = wid >> 2, wc = wid & 3, fr = lane & 15, fq = lane >> 4;
    const int K = g.K, nt = K / BK;
    unsigned voffA[2], voffB[2];
#pragma unroll
    for (int i = 0; i < 2; ++i) { int R, C; stage_rc(tid * 16 + i * 8192, R, C); const int Rb = Epi::PERM ? ((R & ~31) + perm32(R & 31)) : R;
        voffA[i] = (unsigned)(R * K + C) * 2u; voffB[i] = (unsigned)(Rb * K + C) * 2u; }
    const size_t kstep = (size_t)(BK * 2);
    const size_t hstep = (size_t)HALF * K * 2;
    const size_t tstep = 2 * hstep;
    const unsigned ldsw = (unsigned)wid * 1024u;
    const int aoff = lds_byte(wr * 64 + fr, fq * 8), boff = lds_byte(wc * 32 + fr, fq * 8);
#define PG8_SA(b, h) (((b) * 2 + (h)) * HTB)
#define PG8_SB(b, h) ((4 + (b) * 2 + (h)) * HTB)
#define PG8_STAGE(bufoff, gbase, voff) do { _Pragma("unroll") for (int _i = 0; _i < 2; ++_i) \
        __builtin_amdgcn_global_load_lds((const unsigned*)((const char*)(gbase) + (voff)[_i]), (PG8_LAS unsigned*)(lds + (bufoff) + ldsw + _i * 8192), 16, 0, 0); } while (0)
#define PG8_LDA(dst, b, h) do { _Pragma("unroll") for (int m = 0; m < 4; ++m) _Pragma("unroll") for (int k = 0; k < 2; ++k) dst[m][k] = *(const PG8_LAS bf16x8*)(lds + PG8_SA(b, h) + aoff + m * 2048 + k * 1024); } while (0)
#define PG8_LDB(dst, b, h) do { _Pragma("unroll") for (int n = 0; n < 2; ++n) _Pragma("unroll") for (int k = 0; k < 2; ++k) dst[n][k] = *(const PG8_LAS bf16x8*)(lds + PG8_SB(b, h) + boff + n * 2048 + k * 1024); } while (0)
#define PG8_MMA(ai, bj, At, Bt) do { __builtin_amdgcn_s_setprio(1); _Pragma("unroll") for (int m = 0; m < 4; ++m) _Pragma("unroll") for (int n = 0; n < 2; ++n) _Pragma("unroll") for (int k = 0; k < 2; ++k) \
        acc[ai][bj][m][n] = __builtin_amdgcn_mfma_f32_16x16x32_bf16(Bt[n][k], At[m][k], acc[ai][bj][m][n], 0, 0, 0); __builtin_amdgcn_s_setprio(0); } while (0)
#define PG8_WAIT_V(n) asm volatile("s_waitcnt vmcnt(" #n ")" ::: "memory")
#define PG8_WAIT_L(n) asm volatile("s_waitcnt lgkmcnt(" #n ")" ::: "memory")
#define PG8_BAR __builtin_amdgcn_s_barrier()
#define PG8_SCHED __builtin_amdgcn_sched_barrier(0)
    Unit cur, nxt; int ui = 0;
    if (!S.next(0, cur)) return;
    f32x4 acc[2][2][4][2];
#pragma unroll
    for (int a = 0; a < 2; ++a)
#pragma unroll
        for (int b = 0; b < 2; ++b)
#pragma unroll
            for (int m = 0; m < 4; ++m)
#pragma unroll
                for (int n = 0; n < 2; ++n) acc[a][b][m][n] = (f32x4){0.f, 0.f, 0.f, 0.f};
    bf16x8 At[4][2], B0[2][2], B1[2][2];
    const char* cA = (const char*)g.A + (size_t)cur.pm * tstep; const char* cB = (const char*)g.Bt + (size_t)cur.pn * tstep;
    S.a_ready(cur);
    if constexpr (SP2) {
        PG8_STAGE(PG8_SB(0, 0), cB, voffB); PG8_STAGE(PG8_SB(0, 1), cB + hstep, voffB); PG8_STAGE(PG8_SA(0, 0), cA, voffA); PG8_STAGE(PG8_SA(0, 1), cA + hstep, voffA);
        if (wr == 1) PG8_BAR;
        PG8_WAIT_V(2); PG8_BAR;
        PG8_STAGE(PG8_SB(1, 0), cB + kstep, voffB); PG8_STAGE(PG8_SA(1, 0), cA + kstep, voffA); PG8_STAGE(PG8_SB(1, 1), cB + hstep + kstep, voffB);
        PG8_WAIT_V(6); PG8_BAR;
    } else {
        PG8_STAGE(PG8_SB(0, 0), cB, voffB); PG8_STAGE(PG8_SA(0, 0), cA, voffA); PG8_STAGE(PG8_SB(0, 1), cB + hstep, voffB); PG8_STAGE(PG8_SA(0, 1), cA + hstep, voffA);
        if (wr == 1) PG8_BAR;
        PG8_WAIT_V(4); PG8_BAR;
        PG8_STAGE(PG8_SB(1, 0), cB + kstep, voffB); PG8_STAGE(PG8_SA(1, 0), cA + kstep, voffA); PG8_STAGE(PG8_SB(1, 1), cB + hstep + kstep, voffB);
        PG8_WAIT_V(6); PG8_BAR;
    }
    for (;;) {
        const bool has_next = S.next(ui + 1, nxt);
        const char* nA = has_next ? (const char*)g.A + (size_t)nxt.pm * tstep : cA; const char* nB = has_next ? (const char*)g.Bt + (size_t)nxt.pn * tstep : cB;
        for (int t = 0; t < nt; t += 2) {
            const bool last = (t == nt - 2);
            const char* a1 = cA + (size_t)(t + 1) * kstep;
            const char* a2 = last ? nA : cA + (size_t)(t + 2) * kstep; const char* b2 = last ? nB : cB + (size_t)(t + 2) * kstep;
            const char* a3 = a2 + kstep; const char* b3 = b2 + kstep;
            if (last && has_next) S.a_ready(nxt);
            if constexpr (SP2) {
            PG8_LDB(B0, 0, 0); PG8_LDB(B1, 0, 1); PG8_SCHED; PG8_LDA(At, 0, 0); PG8_STAGE(PG8_SA(1, 1), a1 + hstep, voffA);
            PG8_WAIT_V(8); PG8_WAIT_L(0); PG8_BAR; PG8_MMA(0, 0, At, B0); PG8_MMA(0, 1, At, B1); PG8_BAR; PG8_SCHED;
            PG8_LDA(At, 0, 1); PG8_STAGE(PG8_SB(0, 0), b2, voffB); PG8_STAGE(PG8_SB(0, 1), b2 + hstep, voffB); PG8_STAGE(PG8_SA(0, 0), a2, voffA);
            PG8_WAIT_V(8); PG8_WAIT_L(0); PG8_BAR; PG8_MMA(1, 0, At, B0); PG8_MMA(1, 1, At, B1); PG8_BAR; PG8_SCHED;
            PG8_LDB(B0, 1, 0); PG8_LDB(B1, 1, 1); PG8_SCHED; PG8_LDA(At, 1, 0); PG8_STAGE(PG8_SA(0, 1), a2 + hstep, voffA);
            PG8_WAIT_V(8); PG8_WAIT_L(0); PG8_BAR; PG8_MMA(0, 0, At, B0); PG8_MMA(0, 1, At, B1); PG8_BAR; PG8_SCHED;
            PG8_LDA(At, 1, 1); PG8_STAGE(PG8_SB(1, 0), b3, voffB); PG8_STAGE(PG8_SB(1, 1), b3 + hstep, voffB); PG8_STAGE(PG8_SA(1, 0), a3, voffA);
            PG8_WAIT_V(8); PG8_WAIT_L(0); PG8_BAR; PG8_MMA(1, 0, At, B0); PG8_MMA(1, 1, At, B1); PG8_BAR; PG8_SCHED;
            } else {
            PG8_LDB(B0, 0, 0); PG8_SCHED; PG8_LDA(At, 0, 0); PG8_STAGE(PG8_SA(1, 1), a1 + hstep, voffA);
            PG8_WAIT_L(8); PG8_BAR; PG8_WAIT_L(0); PG8_MMA(0, 0, At, B0); PG8_BAR; PG8_SCHED;
            PG8_LDB(B1, 0, 1); PG8_STAGE(PG8_SB(0, 0), b2, voffB);
            PG8_BAR; PG8_WAIT_L(0); PG8_MMA(0, 1, At, B1); PG8_BAR;
            PG8_LDA(At, 0, 1); PG8_STAGE(PG8_SA(0, 0), a2, voffA);
            PG8_BAR; PG8_WAIT_L(0); PG8_MMA(1, 0, At, B0); PG8_BAR; PG8_SCHED;
            PG8_STAGE(PG8_SB(0, 1), b2 + hstep, voffB);
            PG8_WAIT_V(6); PG8_BAR; PG8_MMA(1, 1, At, B1); PG8_BAR;
            PG8_LDB(B0, 1, 0); PG8_SCHED; PG8_LDA(At, 1, 0); PG8_STAGE(PG8_SA(0, 1), a2 + hstep, voffA);
            PG8_WAIT_L(8); PG8_BAR; PG8_WAIT_L(0); PG8_MMA(0, 0, At, B0); PG8_BAR; PG8_SCHED;
            PG8_LDB(B1, 1, 1); PG8_STAGE(PG8_SB(1, 0), b3, voffB);
            PG8_BAR; PG8_WAIT_L(0); PG8_MMA(0, 1, At, B1); PG8_BAR;
            PG8_LDA(At, 1, 1); PG8_STAGE(PG8_SA(1, 0), a3, voffA);
            PG8_BAR; PG8_WAIT_L(0); PG8_MMA(1, 0, At, B0); PG8_BAR; PG8_SCHED;
            PG8_STAGE(PG8_SB(1, 1), b3 + hstep, voffB);
            PG8_WAIT_V(6); PG8_BAR; PG8_MMA(1, 1, At, B1); PG8_BAR;
            }
        }
        if constexpr (ALIGN_EPI) { if (wr == 0) PG8_BAR; }
        if constexpr (!Epi::AFTER_DRAIN) { E(acc, cur, wr, wc, fr, fq); S.done(cur); }
        if (!has_next) break;
#pragma unroll
        for (int a = 0; a < 2; ++a)
#pragma unroll
            for (int b = 0; b < 2; ++b)
#pragma unroll
                for (int m = 0; m < 4; ++m)
#pragma unroll
                    for (int n = 0; n < 2; ++n) acc[a][b][m][n] = (f32x4){0.f, 0.f, 0.f, 0.f};
        cur = nxt; cA = nA; cB = nB; ++ui;
        if constexpr (ALIGN_EPI) { if (wr == 1) PG8_BAR; }
    }
    PG8_WAIT_V(0);
    if constexpr (!ALIGN_EPI) { if (wr == 0) PG8_BAR; }
    PG8_BAR;
    if constexpr (Epi::AFTER_DRAIN) { E.fused(acc, cur, wr, wc, fr, fq, lds, wid, lane); S.done(cur); }
#undef PG8_SA
#undef PG8_SB
#undef PG8_STAGE
#undef PG8_LDA
#undef PG8_LDB
#undef PG8_MMA
#undef PG8_WAIT_V
#undef PG8_WAIT_L
#undef PG8_BAR
#undef PG8_SCHED
}
}

#define LAS __attribute__((address_space(3)))
typedef pg8::bf16_t bf16_t;
typedef pg8::bf16x8 bf16x8;
typedef pg8::f32x4 f32x4;
typedef pg8::u32x4 u32x4;
typedef float f32x16 __attribute__((ext_vector_type(16)));
typedef unsigned u32x2 __attribute__((ext_vector_type(2)));

constexpr int D = 1024, NB = 8, SEQ = 2048, M = NB * SEQ, FF = 4096, INC = 3328, HGW = 512, NMOD6 = 6 * D;
constexpr float EPS = 1e-6f;
constexpr size_t MiB = 1u << 20;
constexpr size_t WS_CTL = 0, CTL_BYTES = 1 * MiB;
constexpr size_t CT_COND = 0, CT_ROWSS = 196608, CT_LBT = 458752;
constexpr size_t WS_WIN = 1 * MiB, WS_WOUT = 14 * MiB, WS_W1 = 18 * MiB, WS_W2 = 34 * MiB;
constexpr size_t WS_ABUF = 50 * MiB;
constexpr size_t WS_QH = 82 * MiB, WS_LF = 98 * MiB, WS_VH = 130 * MiB, WS_GH = 146 * MiB, WS_AQ = 162 * MiB, WS_AK = 178 * MiB, WS_VT = 182 * MiB;
constexpr size_t WS_ST = 186 * MiB, WS_G = 250 * MiB, WS_RSP = 251 * MiB, WS_END = 252 * MiB;
constexpr size_t WS_YRAW1 = 82 * MiB, WS_U = 82 * MiB, WS_YRAW2 = 210 * MiB;
constexpr int LDS_BYTES = 147456;

__device__ __forceinline__ float bf2f(unsigned short h) { return __uint_as_float(((unsigned)h) << 16); }
__device__ __forceinline__ float bflo(unsigned w) { return __uint_as_float(w << 16); }
__device__ __forceinline__ float bfhi(unsigned w) { return __uint_as_float(w & 0xffff0000u); }
__device__ __forceinline__ unsigned pk2(float lo, float hi) { return pg8::cvt_pk_bf16(lo, hi); }
__device__ __forceinline__ unsigned short f2bf(float f) { return (unsigned short)(pg8::cvt_pk_bf16(f, 0.f) & 0xffffu); }
__device__ __forceinline__ float wave_sum(float v) {
#pragma unroll
    for (int o = 1; o < 64; o <<= 1) v += __shfl_xor(v, o);
    return v;
}
__device__ __forceinline__ int otid() { int t = threadIdx.x; asm volatile("" : "+v"(t)); return t; }
__device__ __forceinline__ float fexp(float x) { return __builtin_amdgcn_exp2f(x * 1.4426950408889634f); }
__device__ __forceinline__ float siluf(float x) { return x * __builtin_amdgcn_rcpf(1.f + fexp(-x)); }

struct EpiIn {
    static constexpr bool PERM = true, AFTER_DRAIN = false;
    bf16_t *Qh, *LF, *Vh, *Gh, *AQ, *AK, *VT; const float* lbt;
    __device__ __forceinline__ void operator()(const f32x4 (&acc)[2][2][4][2], const pg8::Unit& u, int wr, int wc, int fr, int fq) const {
        const int row0 = u.pm * 256 + wr * 64 + fr;
        const int pn = u.pn, grp = pn >> 1;
#pragma unroll
        for (int bj = 0; bj < 2; ++bj) {
            const int colt = (pn & 1) * 256 + bj * 128 + wc * 32 + 8 * fq;
            if (pn == 12) {
                const int cc = wc * 32 + 8 * fq;
                if (bj == 0) {
#pragma unroll
                    for (int ai = 0; ai < 2; ++ai)
#pragma unroll
                        for (int m = 0; m < 4; ++m) { const int row = row0 + ai * 128 + m * 16; const f32x4 v0 = acc[ai][bj][m][0], v1 = acc[ai][bj][m][1];
                            u32x4 w; w.x = pk2(v0[0], v0[1]); w.y = pk2(v0[2], v0[3]); w.z = pk2(v1[0], v1[1]); w.w = pk2(v1[2], v1[3]);
                            *(u32x4*)(AK + (size_t)row * 128 + cc) = w; }
                } else {
                    const int kvh = cc >> 6, d0 = cc & 63;
#pragma unroll
                    for (int ai = 0; ai < 2; ++ai)
#pragma unroll
                        for (int m = 0; m < 4; ++m) { const int row = row0 + ai * 128 + m * 16; const int b = row >> 11, s = row & 2047;
                            bf16_t* vp = VT + ((size_t)((b * 2 + kvh) * 64 + d0)) * 2048 + s;
#pragma unroll
                            for (int n = 0; n < 2; ++n)
#pragma unroll
                                for (int i = 0; i < 4; ++i) vp[(size_t)(4 * n + i) * 2048] = f2bf(acc[ai][bj][m][n][i]); }
                }
                continue;
            }
            bf16_t* dst; int mode;
            if (grp == 0) { dst = Qh; mode = 1; } else if (grp == 1) { dst = LF; mode = 2; } else if (grp == 2) { dst = LF + (size_t)M * HGW; mode = 2; }
            else if (grp == 3) { dst = Vh; mode = 0; } else if (grp == 4) { dst = Gh; mode = 1; } else { dst = AQ; mode = 0; }
            f32x4 lb0 = {0.f, 0.f, 0.f, 0.f}, lb1 = {0.f, 0.f, 0.f, 0.f};
            if (mode == 2) { lb0 = *(const f32x4*)(lbt + colt); lb1 = *(const f32x4*)(lbt + colt + 4); }
#pragma unroll
            for (int ai = 0; ai < 2; ++ai)
#pragma unroll
                for (int m = 0; m < 4; ++m) { const int row = row0 + ai * 128 + m * 16; f32x4 v0 = acc[ai][bj][m][0], v1 = acc[ai][bj][m][1];
                    if (mode == 1) {
#pragma unroll
                        for (int i = 0; i < 4; ++i) { v0[i] = siluf(v0[i]); v1[i] = siluf(v1[i]); }
                    } else if (mode == 2) {
#pragma unroll
                        for (int i = 0; i < 4; ++i) {
                            { const float z = v0[i], lb = lb0[i]; const float ls = fminf(z, 0.f) - __logf(1.f + fexp(-fabsf(z))); v0[i] = lb > 0.f ? __logf(lb + (1.f - lb) * fexp(ls)) : ls; }
                            { const float z = v1[i], lb = lb1[i]; const float ls = fminf(z, 0.f) - __logf(1.f + fexp(-fabsf(z))); v1[i] = lb > 0.f ? __logf(lb + (1.f - lb) * fexp(ls)) : ls; }
                        }
                    }
                    u32x4 w; w.x = pk2(v0[0], v0[1]); w.y = pk2(v0[2], v0[3]); w.z = pk2(v1[0], v1[1]); w.w = pk2(v1[2], v1[3]);
                    *(u32x4*)(dst + (size_t)row * HGW + colt) = w; }
        }
    }
};
struct EpiRaw {
    static constexpr bool PERM = true, AFTER_DRAIN = false;
    bf16_t* Y; float* rowss;
    __device__ __forceinline__ void operator()(const f32x4 (&acc)[2][2][4][2], const pg8::Unit& u, int wr, int wc, int fr, int fq) const {
        const int row0 = u.pm * 256 + wr * 64 + fr, col0 = u.pn * 256 + wc * 32 + 8 * fq;
#pragma unroll
        for (int ai = 0; ai < 2; ++ai)
#pragma unroll
            for (int m = 0; m < 4; ++m) { const int row = row0 + ai * 128 + m * 16; float s = 0.f;
#pragma unroll
                for (int bj = 0; bj < 2; ++bj) { const f32x4 v0 = acc[ai][bj][m][0], v1 = acc[ai][bj][m][1];
                    s += (v0[0] * v0[0] + v0[1] * v0[1]) + (v0[2] * v0[2] + v0[3] * v0[3]) + (v1[0] * v1[0] + v1[1] * v1[1]) + (v1[2] * v1[2] + v1[3] * v1[3]);
                    u32x4 w; w.x = pk2(v0[0], v0[1]); w.y = pk2(v0[2], v0[3]); w.z = pk2(v1[0], v1[1]); w.w = pk2(v1[2], v1[3]);
                    *(u32x4*)(Y + (size_t)row * D + col0 + bj * 128) = w; }
                s += __shfl_xor(s, 16); s += __shfl_xor(s, 32);
                if (fq == 0) rowss[(size_t)row * 16 + u.pn * 4 + wc] = s; }
    }
};
struct EpiRelu2 {
    static constexpr bool PERM = true, AFTER_DRAIN = false;
    bf16_t* U;
    __device__ __forceinline__ void operator()(const f32x4 (&acc)[2][2][4][2], const pg8::Unit& u, int wr, int wc, int fr, int fq) const {
        const int row0 = u.pm * 256 + wr * 64 + fr, col0 = u.pn * 256 + wc * 32 + 8 * fq;
#pragma unroll
        for (int ai = 0; ai < 2; ++ai)
#pragma unroll
            for (int m = 0; m < 4; ++m) { const int row = row0 + ai * 128 + m * 16;
#pragma unroll
                for (int bj = 0; bj < 2; ++bj) { f32x4 v0 = acc[ai][bj][m][0], v1 = acc[ai][bj][m][1];
#pragma unroll
                    for (int i = 0; i < 4; ++i) { const float a = fmaxf(v0[i], 0.f), b = fmaxf(v1[i], 0.f); v0[i] = a * a; v1[i] = b * b; }
                    u32x4 w; w.x = pk2(v0[0], v0[1]); w.y = pk2(v0[2], v0[3]); w.z = pk2(v1[0], v1[1]); w.w = pk2(v1[2], v1[3]);
                    *(u32x4*)(U + (size_t)row * FF + col0 + bj * 128) = w; } }
    }
};

__device__ __forceinline__ void transpose_item(const float* W, int K, int N, bf16_t* WT, LAS float* scr, int item, int lane) {
    const int nblk = N / 32, kb = item / nblk, nb = item % nblk, k0 = 64 * kb, n0 = 32 * nb;
#pragma unroll 8
    for (int i = 0; i < 32; ++i) { const int kk = 2 * i + (lane >> 5); scr[kk * 33 + (lane & 31)] = W[(size_t)(k0 + kk) * N + n0 + (lane & 31)]; }
    asm volatile("s_waitcnt lgkmcnt(0)" ::: "memory");
    const int c = lane & 7;
#pragma unroll
    for (int j = 0; j < 4; ++j) { const int n = (lane >> 3) + 8 * j; const LAS float* s = scr + (8 * c) * 33 + n;
        u32x4 o; o.x = pk2(s[0 * 33], s[1 * 33]); o.y = pk2(s[2 * 33], s[3 * 33]); o.z = pk2(s[4 * 33], s[5 * 33]); o.w = pk2(s[6 * 33], s[7 * 33]);
        *(u32x4*)(WT + (size_t)(n0 + n) * K + k0 + 8 * c) = o; }
    asm volatile("s_waitcnt lgkmcnt(0)" ::: "memory");
}

struct Args {
    const float *x, *c, *w_ada, *ada_bias, *lb_logits, *pre_mix, *post_mix, *w_in, *w_out, *hg_gain, *q_gain, *k_gain, *ao_gain, *pre_ff, *post_ff, *w_ff1, *w_ff2;
    float* out; unsigned char* ws; int stop_at, stop_l;
};

template <bool DBG = false>
__device__ __forceinline__ void row_phase(const float* xin, float* xout, const bf16_t* yraw, const float* rowss, const float* post, const float* cond, const float* biasg  , int gidx,
                                          bf16_t* hout, const float* pre, const float* biash  , int shidx, int scidx) {
    const int tid = otid(), lane = tid & 63, wave = tid >> 6;
    const int gw = blockIdx.x * 8 + wave, NGW = gridDim.x * 8;
    const int RPW = (M + NGW - 1) / NGW, rbeg = gw * RPW, rend = (rbeg + RPW < M) ? (rbeg + RPW) : M;
    int bcur = -1;
    f32x4 Gm[4], Am[4], Bm[4];
    f32x4 xn[4]; u32x2 yn[4]; f32x4 pn[4];
#pragma unroll
    for (int j = 0; j < 4; ++j) { xn[j] = (f32x4){0.f, 0.f, 0.f, 0.f}; yn[j] = (u32x2){0u, 0u}; pn[j] = (f32x4){0.f, 0.f, 0.f, 0.f}; Gm[j] = Am[j] = Bm[j] = (f32x4){0.f, 0.f, 0.f, 0.f}; }
#define RP_LOAD(rr) do { _Pragma("unroll") for (int j = 0; j < 4; ++j) { xn[j] = *(const f32x4*)(xin + (size_t)(rr) * D + 256 * j + 4 * lane); \
        if (yraw) { yn[j] = *(const u32x2*)(yraw + (size_t)(rr) * D + 256 * j + 4 * lane); pn[j] = *(const f32x4*)(rowss + (size_t)(rr) * 16 + 4 * j); } } } while (0)
    if (rbeg < rend) RP_LOAD(rbeg);
#pragma unroll 1
    for (int r = rbeg; r < rend; ++r) {
        f32x4 xv[4]; u32x2 yw[4]; f32x4 pv[4];
#pragma unroll
        for (int j = 0; j < 4; ++j) { xv[j] = xn[j]; yw[j] = yn[j]; pv[j] = pn[j]; }
        if (r + 1 < rend) RP_LOAD(r + 1);
        const int b = r >> 11;
        if (b != bcur) { bcur = b;
#pragma unroll
            for (int j = 0; j < 4; ++j) { const int c = 256 * j + 4 * lane;
                if (yraw) { const f32x4 pg = *(const f32x4*)(post + c); const f32x4 gc = *(const f32x4*)(cond + (size_t)b * NMOD6 + gidx * D + c), gb = *(const f32x4*)(biasg + gidx * D + c);
                    Gm[j] = (gc + gb) * pg; }
                if (hout) { const f32x4 pg = *(const f32x4*)(pre + c);
                    const f32x4 sc = *(const f32x4*)(cond + (size_t)b * NMOD6 + scidx * D + c), sb = *(const f32x4*)(biash + scidx * D + c);
                    const f32x4 sh = *(const f32x4*)(cond + (size_t)b * NMOD6 + shidx * D + c), hb = *(const f32x4*)(biash + shidx * D + c);
                    Am[j] = pg * (sc + sb + 1.f); Bm[j] = sh + hb; } } }
        if (yraw) {
            float ssum = 0.f;
#pragma unroll
            for (int q = 0; q < 4; ++q) ssum += (pv[q][0] + pv[q][1]) + (pv[q][2] + pv[q][3]);
            const float rs = rsqrtf(ssum * (1.f / D) + EPS);
#pragma unroll
            for (int j = 0; j < 4; ++j) { const int c = 256 * j + 4 * lane;
                xv[j][0] += Gm[j][0] * (bflo(yw[j].x) * rs); xv[j][1] += Gm[j][1] * (bfhi(yw[j].x) * rs);
                xv[j][2] += Gm[j][2] * (bflo(yw[j].y) * rs); xv[j][3] += Gm[j][3] * (bfhi(yw[j].y) * rs);
                *(f32x4*)(xout + (size_t)r * D + c) = xv[j]; }
        }
        if (hout) {
            float s = 0.f;
#pragma unroll
            for (int j = 0; j < 4; ++j) s += (xv[j][0] * xv[j][0] + xv[j][1] * xv[j][1]) + (xv[j][2] * xv[j][2] + xv[j][3] * xv[j][3]);
            const float rs2 = rsqrtf(wave_sum(s) * (1.f / D) + EPS);
#pragma unroll
            for (int j = 0; j < 4; ++j) { const int c = 256 * j + 4 * lane;
                float h[4];
#pragma unroll
                for (int i = 0; i < 4; ++i) h[i] = xv[j][i] * rs2 * Am[j][i] + Bm[j][i];
                u32x2 w; w.x = pk2(h[0], h[1]); w.y = pk2(h[2], h[3]);
                *(u32x2*)(hout + (size_t)r * D + c) = w; }
        }
    }
#undef RP_LOAD
}

__device__ __forceinline__ void attn_prep(bf16_t* AQ, bf16_t* AK, const float* qg, const float* kg) {
    const int tid = otid(), lane = tid & 63, wave = tid >> 6;
    const int gw = blockIdx.x * 8 + wave, NGW = gridDim.x * 8;
    const float invf = __builtin_amdgcn_exp2f(-(float)(lane & 15) * (13.287712379549449f / 16.f));
    const float qgl = qg[lane], kgl = kg[lane];
    constexpr float QSCALE = 0.125f * 1.4426950408889634f;
    for (int r = gw; r < M; r += NGW) {
        const int s = r & 2047; const float pos = (float)((lane >> 5) ? (s & 63) : (s >> 6));
        const float ang = pos * invf; const float cs = __cosf(ang), sn = __sinf(ang);
#pragma unroll
        for (int h = 0; h < 10; ++h) {
            bf16_t* p = (h < 8) ? (AQ + (size_t)r * 512 + h * 64 + lane) : (AK + (size_t)r * 128 + (h - 8) * 64 + lane);
            const float x = bf2f(*p);
            const float rs = rsqrtf(wave_sum(x * x) * (1.f / 64.f) + EPS);
            const float y = x * rs * (h < 8 ? qgl : kgl);
            const float pr = __shfl_xor(y, 16);
            float o = (lane & 16) ? (y * cs + pr * sn) : (y * cs - pr * sn);
            if (h < 8) o *= QSCALE;
            *p = f2bf(o);
        }
    }
}

template <bool fixm>
__device__ __forceinline__ void attn_units(LAS unsigned char* lds, const bf16_t* QP, const bf16_t* KP, const bf16_t* VT, bf16_t* ymix, const float* og, bf16_t* UT, const float* G, const float sinit);
__device__ __forceinline__ void attn_phase(LAS unsigned char* lds, const bf16_t* QP, const bf16_t* KP, const bf16_t* VT, bf16_t* ymix, const float* og, bf16_t* UT, const float* G, const float* qg, const float* kg) {
    const int tid = otid(), wid = tid >> 6, lane = tid & 63, r32 = lane & 31, hi = lane >> 5;
    float mq = fabsf(qg[lane]), mk = fabsf(kg[lane]);
#pragma unroll
    for (int o = 1; o < 64; o <<= 1) { mq = fmaxf(mq, __shfl_xor(mq, o)); mk = fmaxf(mk, __shfl_xor(mk, o)); }
    const float B2 = 8.f * mq * mk * 1.4426950408889634f * 1.01f;
    const bool fixm0 = __builtin_amdgcn_readfirstlane((int)(B2 <= 40.f)) != 0;
    if (fixm0) attn_units<true>(lds, QP, KP, VT, ymix, og, UT, G, -B2); else attn_units<false>(lds, QP, KP, VT, ymix, og, UT, G, 0.f);
}
template <bool fixm>
__device__ __forceinline__ void attn_units(LAS unsigned char* lds, const bf16_t* QP, const bf16_t* KP, const bf16_t* VT, bf16_t* ymix, const float* og, bf16_t* UT, const float* G, const float sinit) {
    const int tid = otid(), wid = tid >> 6, lane = tid & 63, r32 = lane & 31, hi = lane >> 5;
    const int skey = tid >> 3, sch = tid & 7;
    const unsigned soff = skey * 144 + sch * 16;
    for (int unit = blockIdx.x; unit < 512; unit += gridDim.x) {
        const int b = unit >> 6, kvh = (unit >> 5) & 1, qb = unit & 31;
        const int head = kvh * 4 + (wid >> 1), tok0 = qb * 64 + (wid & 1) * 32;
        const bf16_t* qp = QP + (size_t)(b * 2048 + tok0 + r32) * 512 + head * 64 + 8 * hi;
        bf16x8 qf[4];
#pragma unroll
        for (int ks = 0; ks < 4; ++ks) qf[ks] = *(const bf16x8*)(qp + 16 * ks);
        const bf16_t* kg = KP + (size_t)(b * 2048 + skey) * 128 + kvh * 64 + 8 * sch;
        const bf16_t* vg = VT + ((size_t)((b * 2 + kvh) * 64 + skey)) * 2048 + 8 * sch;
        u32x4 kr = *(const u32x4*)kg, vr = *(const u32x4*)vg;
        *(LAS u32x4*)(lds + soff) = kr; *(LAS u32x4*)(lds + 18432 + soff) = vr;
        __syncthreads();
        f32x16 o0, o1;
#pragma unroll
        for (int i = 0; i < 16; ++i) { o0[i] = 0.f; o1[i] = 0.f; }
        float mrun = -INFINITY, lrun = 0.f;
        const int h2item = blockIdx.x * 512 + tid; const bool h2on = (unit == (int)blockIdx.x) && (h2item < 64 * 2048);
        bf16_t* hp = UT; const float* gp = G; float hS[8]; u32x4 huw = {0u, 0u, 0u, 0u}; f32x4 hg0 = {0.f, 0.f, 0.f, 0.f}, hg1 = {0.f, 0.f, 0.f, 0.f};
#pragma unroll
        for (int i = 0; i < 8; ++i) hS[i] = 0.f;
        if (h2on) { const int seq = h2item >> 11, rem = h2item & 2047, e = rem >> 4, d0 = (rem & 15) * 8;
            hp = UT + (((size_t)seq * 32) * 128 + e) * 128 + d0; gp = G + (size_t)seq * 32 * 128 + d0;
            huw = *(const u32x4*)hp; hg0 = *(const f32x4*)gp; hg1 = *(const f32x4*)(gp + 4); }
        for (int j = 0; j < 32; ++j) {
            if (j + 1 < 32) { kr = *(const u32x4*)(kg + (size_t)(j + 1) * 64 * 128); vr = *(const u32x4*)(vg + (j + 1) * 64); }
            const LAS unsigned char* kb = lds + (j & 1) * 9216; const LAS unsigned char* vb = lds + 18432 + (j & 1) * 9216;
            f32x16 s0, s1;
#pragma unroll
            for (int i = 0; i < 16; ++i) { s0[i] = sinit; s1[i] = sinit; }
#pragma unroll
            for (int ks = 0; ks < 4; ++ks) {
                const bf16x8 a0 = *(const LAS bf16x8*)(kb + r32 * 144 + (16 * ks + 8 * hi) * 2);
                const bf16x8 a1 = *(const LAS bf16x8*)(kb + (32 + r32) * 144 + (16 * ks + 8 * hi) * 2);
                s0 = __builtin_amdgcn_mfma_f32_32x32x16_bf16(a0, qf[ks], s0, 0, 0, 0);
                s1 = __builtin_amdgcn_mfma_f32_32x32x16_bf16(a1, qf[ks], s1, 0, 0, 0);
            }
            if (h2on) {
                u32x4 o; o.x = pk2(hS[0], hS[1]); o.y = pk2(hS[2], hS[3]); o.z = pk2(hS[4], hS[5]); o.w = pk2(hS[6], hS[7]);
                *(u32x4*)(hp + (size_t)j * 16384) = o;
                hS[0] = hg0[0] * hS[0] + bflo(huw.x); hS[1] = hg0[1] * hS[1] + bfhi(huw.x); hS[2] = hg0[2] * hS[2] + bflo(huw.y); hS[3] = hg0[3] * hS[3] + bfhi(huw.y);
                hS[4] = hg1[0] * hS[4] + bflo(huw.z); hS[5] = hg1[1] * hS[5] + bfhi(huw.z); hS[6] = hg1[2] * hS[6] + bflo(huw.w); hS[7] = hg1[3] * hS[7] + bfhi(huw.w);
                if (j + 1 < 32) { huw = *(const u32x4*)(hp + (size_t)(j + 1) * 16384); hg0 = *(const f32x4*)(gp + (j + 1) * 128); hg1 = *(const f32x4*)(gp + (j + 1) * 128 + 4); }
            }
            if (fixm) {
                float ps0 = 0.f, ps1 = 0.f;
#pragma unroll
                for (int i = 0; i < 16; ++i) { s0[i] = __builtin_amdgcn_exp2f(s0[i]); s1[i] = __builtin_amdgcn_exp2f(s1[i]); ps0 += s0[i]; ps1 += s1[i]; }
                lrun += ps0 + ps1;
            } else {
                float mx = fmaxf(s0[0], s1[0]);
#pragma unroll
                for (int i = 1; i < 16; ++i) mx = fmaxf(mx, fmaxf(s0[i], s1[i]));
                mx = fmaxf(mx, __shfl_xor(mx, 32));
                const float mnew = fmaxf(mrun, mx); const float alpha = __builtin_amdgcn_exp2f(mrun - mnew); mrun = mnew;
                float ps = 0.f;
#pragma unroll
                for (int i = 0; i < 16; ++i) { s0[i] = __builtin_amdgcn_exp2f(s0[i] - mnew); s1[i] = __builtin_amdgcn_exp2f(s1[i] - mnew); ps += s0[i] + s1[i]; }
                lrun = lrun * alpha + ps;
#pragma unroll
                for (int i = 0; i < 16; ++i) { o0[i] *= alpha; o1[i] *= alpha; }
            }
#pragma unroll
            for (int mb = 0; mb < 2; ++mb)
#pragma unroll
                for (int u = 0; u < 2; ++u) {
                    u32x4 pw;
                    if (mb == 0) { pw.x = pk2(s0[8 * u + 0], s0[8 * u + 1]); pw.y = pk2(s0[8 * u + 2], s0[8 * u + 3]); pw.z = pk2(s0[8 * u + 4], s0[8 * u + 5]); pw.w = pk2(s0[8 * u + 6], s0[8 * u + 7]); }
                    else         { pw.x = pk2(s1[8 * u + 0], s1[8 * u + 1]); pw.y = pk2(s1[8 * u + 2], s1[8 * u + 3]); pw.z = pk2(s1[8 * u + 4], s1[8 * u + 5]); pw.w = pk2(s1[8 * u + 6], s1[8 * u + 7]); }
                    const bf16x8 pb = __builtin_bit_cast(bf16x8, pw);
                    const int keybase = 32 * mb + 16 * u;
                    const u32x2 l0 = *(const LAS u32x2*)(vb + r32 * 144 + (keybase + 4 * hi) * 2), h0 = *(const LAS u32x2*)(vb + r32 * 144 + (keybase + 8 + 4 * hi) * 2);
                    const u32x2 l1 = *(const LAS u32x2*)(vb + (32 + r32) * 144 + (keybase + 4 * hi) * 2), h1 = *(const LAS u32x2*)(vb + (32 + r32) * 144 + (keybase + 8 + 4 * hi) * 2);
                    u32x4 a0w; a0w.x = l0.x; a0w.y = l0.y; a0w.z = h0.x; a0w.w = h0.y;
                    u32x4 a1w; a1w.x = l1.x; a1w.y = l1.y; a1w.z = h1.x; a1w.w = h1.y;
                    o0 = __builtin_amdgcn_mfma_f32_32x32x16_bf16(__builtin_bit_cast(bf16x8, a0w), pb, o0, 0, 0, 0);
                    o1 = __builtin_amdgcn_mfma_f32_32x32x16_bf16(__builtin_bit_cast(bf16x8, a1w), pb, o1, 0, 0, 0);
                }
            if (j + 1 < 32) { const unsigned nb = ((j + 1) & 1) * 9216; *(LAS u32x4*)(lds + nb + soff) = kr; *(LAS u32x4*)(lds + 18432 + nb + soff) = vr; }
            __syncthreads();
        }
        const float l = lrun + __shfl_xor(lrun, 32); const float inv = 1.f / l;
        float ss = 0.f;
#pragma unroll
        for (int i = 0; i < 16; ++i) { o0[i] *= inv; o1[i] *= inv; ss += o0[i] * o0[i] + o1[i] * o1[i]; }
        ss += __shfl_xor(ss, 32);
        const float rs = rsqrtf(ss * (1.f / 64.f) + EPS);
        bf16_t* yp = ymix + (size_t)(b * 2048 + tok0 + r32) * D + 512 + head * 64;
#pragma unroll
        for (int q4 = 0; q4 < 4; ++q4) {
            { const int d0 = 8 * q4 + 4 * hi; const f32x4 g = *(const f32x4*)(og + d0);
              u32x2 w; w.x = pk2(o0[4 * q4 + 0] * rs * g[0], o0[4 * q4 + 1] * rs * g[1]); w.y = pk2(o0[4 * q4 + 2] * rs * g[2], o0[4 * q4 + 3] * rs * g[3]); *(u32x2*)(yp + d0) = w; }
            { const int d0 = 32 + 8 * q4 + 4 * hi; const f32x4 g = *(const f32x4*)(og + d0);
              u32x2 w; w.x = pk2(o1[4 * q4 + 0] * rs * g[0], o1[4 * q4 + 1] * rs * g[1]); w.y = pk2(o1[4 * q4 + 2] * rs * g[2], o1[4 * q4 + 3] * rs * g[3]); *(u32x2*)(yp + d0) = w; }
        }
    }
}

__device__ __forceinline__ void h1_phase(LAS unsigned char* lds, const bf16_t* LF, const bf16_t* Vh, bf16_t* UT, float* G) {
    const int tid = otid(), wid = tid >> 6, lane = tid & 63, fr = lane & 15, fq = lane >> 4;
    const int d = tid & 127, I = tid >> 7;
    LAS float* Ts = (LAS float*)lds; LAS unsigned char* kdT = lds + 2048; LAS unsigned char* vT = lds + 2048 + 18432;
    for (int unit = blockIdx.x; unit < 2048; unit += gridDim.x) {
        const int c = unit & 31, dir = (unit >> 5) & 1, h = (unit >> 6) & 3, n = unit >> 8;
        float beta[16], lf[16]; unsigned short vv[16];
        const bf16_t* lfb = LF + ((size_t)dir * M + (size_t)n * 2048) * HGW + h * 128; const bf16_t* vhb = Vh + (size_t)n * 2048 * HGW + h * 128;
        unsigned bo0 = (unsigned)d * 2u; asm volatile("" : "+v"(bo0));
#pragma unroll
        for (int j = 0; j < 16; ++j) { const int f = 64 * c + 16 * I + j; const int tok = dir ? (2047 - f) : f; const unsigned bo = (unsigned)(tok * (HGW * 2)) + bo0;
            lf[j] = bf2f(*(const bf16_t*)((const char*)lfb + bo)); vv[j] = *(const bf16_t*)((const char*)vhb + bo); }
        float run = 0.f;
#pragma unroll
        for (int j = 0; j < 16; ++j) { run += lf[j]; beta[j] = run; }
        Ts[I * 128 + d] = run;
        __syncthreads();
        const float T0 = Ts[d], T1 = Ts[128 + d], T2 = Ts[256 + d], T3 = Ts[384 + d];
        const float r4 = (T0 + T1) + (T2 + T3);
        const float rI = (I > 0 ? T0 : 0.f) + (I > 1 ? T1 : 0.f) + (I > 2 ? T2 : 0.f);
        const float base = r4 - rI;
        unsigned kw[8], vw[8];
#pragma unroll
        for (int j = 0; j < 8; ++j) {
            const float k0 = (1.f - fexp(lf[2 * j])) * fexp(base - beta[2 * j]), k1 = (1.f - fexp(lf[2 * j + 1])) * fexp(base - beta[2 * j + 1]);
            kw[j] = pk2(k0, k1); vw[j] = (unsigned)vv[2 * j] | ((unsigned)vv[2 * j + 1] << 16); }
        { u32x4 a; a.x = kw[0]; a.y = kw[1]; a.z = kw[2]; a.w = kw[3]; u32x4 bq; bq.x = kw[4]; bq.y = kw[5]; bq.z = kw[6]; bq.w = kw[7];
          *(LAS u32x4*)(kdT + d * 144 + I * 32) = a; *(LAS u32x4*)(kdT + d * 144 + I * 32 + 16) = bq; }
        { u32x4 a; a.x = vw[0]; a.y = vw[1]; a.z = vw[2]; a.w = vw[3]; u32x4 bq; bq.x = vw[4]; bq.y = vw[5]; bq.z = vw[6]; bq.w = vw[7];
          *(LAS u32x4*)(vT + d * 144 + I * 32) = a; *(LAS u32x4*)(vT + d * 144 + I * 32 + 16) = bq; }
        if (I == 0) G[(size_t)unit * 128 + d] = fexp(r4);
        __syncthreads();
        bf16x8 bfr[2];
#pragma unroll
        for (int ks = 0; ks < 2; ++ks) bfr[ks] = *(const LAS bf16x8*)(vT + (16 * wid + fr) * 144 + (32 * ks + 8 * fq) * 2);
        bf16_t* up = UT + ((size_t)unit * 128 + 16 * wid + fr) * 128 + 4 * fq;
#pragma unroll
        for (int mb = 0; mb < 8; ++mb) {
            f32x4 acc = {0.f, 0.f, 0.f, 0.f};
#pragma unroll
            for (int ks = 0; ks < 2; ++ks) { const bf16x8 a = *(const LAS bf16x8*)(kdT + (16 * mb + fr) * 144 + (32 * ks + 8 * fq) * 2);
                acc = __builtin_amdgcn_mfma_f32_16x16x32_bf16(a, bfr[ks], acc, 0, 0, 0); }
            u32x2 w; w.x = pk2(acc[0], acc[1]); w.y = pk2(acc[2], acc[3]);
            *(u32x2*)(up + 16 * mb) = w;
        }
        __syncthreads();
    }
}

__device__ __forceinline__ void h2_phase(bf16_t* UT, const float* G) {
    const int gt = blockIdx.x * 512 + otid(), GN = gridDim.x * 512;
    for (int item = gt + GN; item < 64 * 2048; item += GN) {
        const int seq = item >> 11, rem = item & 2047, e = rem >> 4, d0 = (rem & 15) * 8;
        float S[8];
#pragma unroll
        for (int i = 0; i < 8; ++i) S[i] = 0.f;
#pragma unroll 4
        for (int c = 0; c < 32; ++c) {
            const size_t unit = (size_t)seq * 32 + c;
            bf16_t* p = UT + (unit * 128 + e) * 128 + d0;
            const u32x4 uw = *(const u32x4*)p;
            const f32x4 g0 = *(const f32x4*)(G + unit * 128 + d0), g1 = *(const f32x4*)(G + unit * 128 + d0 + 4);
            u32x4 o; o.x = pk2(S[0], S[1]); o.y = pk2(S[2], S[3]); o.z = pk2(S[4], S[5]); o.w = pk2(S[6], S[7]);
            *(u32x4*)p = o;
            S[0] = g0[0] * S[0] + bflo(uw.x); S[1] = g0[1] * S[1] + bfhi(uw.x); S[2] = g0[2] * S[2] + bflo(uw.y); S[3] = g0[3] * S[3] + bfhi(uw.y);
            S[4] = g1[0] * S[4] + bflo(uw.z); S[5] = g1[1] * S[5] + bfhi(uw.z); S[6] = g1[2] * S[6] + bflo(uw.w); S[7] = g1[3] * S[7] + bfhi(uw.w);
        }
    }
}

constexpr int H3_TS = 0, H3_RED = 2048, H3_RSV = 4096, H3_QT = 4352, H3_QB = 21760, H3_KV = 39168, H3_VT = 82688, H3_P = 101120, H3_END = 110336;
__device__ __forceinline__ void h3_load(int unit, int dir, unsigned bo0, int I, const bf16_t* LF, const bf16_t* Qh, const bf16_t* Vh, unsigned (&lq)[16], unsigned (&vw)[8]) {
    const int c = unit & 31, h = (unit >> 5) & 3, n = unit >> 7;
    const size_t ub = ((size_t)n * 2048 + 64 * c) * HGW + h * 128;
    const bf16_t* lfb = LF + (size_t)dir * M * HGW + ub; const bf16_t* qhb = Qh + ub; const bf16_t* vhb = Vh + ub;
#pragma unroll
    for (int j = 0; j < 16; ++j) { const int t = 16 * I + j; const int p = dir ? (63 - t) : t; const unsigned bo = (unsigned)(p * (HGW * 2)) + bo0;
        lq[j] = (unsigned)*(const bf16_t*)((const char*)lfb + bo) | ((unsigned)*(const bf16_t*)((const char*)qhb + bo) << 16);
        const unsigned v = (unsigned)*(const bf16_t*)((const char*)vhb + bo);
        if (j & 1) vw[j >> 1] |= v << 16; else vw[j >> 1] = v; }
}
__device__ __forceinline__ void h3_phase(LAS unsigned char* lds, const bf16_t* LF, const bf16_t* Qh, const bf16_t* Vh, const bf16_t* Gh, const bf16_t* ST, const float* hgain, bf16_t* ymix) {
    const int tid = otid(), wid = tid >> 6, lane = tid & 63, fr = lane & 15, fq = lane >> 4;
    const int d = tid & 127, I = tid >> 7;
    LAS float* Ts = (LAS float*)(lds + H3_TS); LAS float* red = (LAS float*)(lds + H3_RED); LAS float* rsv = (LAS float*)(lds + H3_RSV);
    LAS unsigned char* qt = lds + H3_QT; LAS unsigned char* qbL = lds + H3_QB; LAS unsigned char* kv = lds + H3_KV; LAS unsigned char* vT = lds + H3_VT; LAS unsigned char* P = lds + H3_P;
    for (int i = tid; i < 9216 / 4; i += 512) ((LAS unsigned*)P)[i] = 0u;
    __syncthreads();
    int ndu = 0;
    for (int u = blockIdx.x; u < 1024; u += gridDim.x) ndu += 2;
    unsigned lqn[16], vwn[8];
#pragma unroll
    for (int j = 0; j < 16; ++j) lqn[j] = 0u;
#pragma unroll
    for (int j = 0; j < 8; ++j) vwn[j] = 0u;
    if (ndu > 0) { unsigned bo0 = (unsigned)d * 2u; asm volatile("" : "+v"(bo0)); h3_load(blockIdx.x, 0, bo0, I, LF, Qh, Vh, lqn, vwn); }
    f32x4 acc[4];
#pragma unroll
    for (int mb = 0; mb < 4; ++mb) acc[mb] = (f32x4){0.f, 0.f, 0.f, 0.f};
#pragma unroll 1
    for (int du = 0; du < ndu; ++du) {
        const int unit = blockIdx.x + (du >> 1) * gridDim.x, dir = du & 1;
        const int c = unit & 31, h = (unit >> 5) & 3, n = unit >> 7;
        unsigned lq[16], vw[8];
#pragma unroll
        for (int j = 0; j < 16; ++j) lq[j] = lqn[j];
#pragma unroll
        for (int j = 0; j < 8; ++j) vw[j] = vwn[j];
#if 0
        if (du + 1 < ndu) { unsigned bo0 = (unsigned)d * 2u; asm volatile("" : "+v"(bo0)); h3_load(blockIdx.x + ((du + 1) >> 1) * gridDim.x, (du + 1) & 1, bo0, I, LF, Qh, Vh, lqn, vwn); }
#else
        { unsigned bo0 = (unsigned)d * 2u; asm volatile("" : "+v"(bo0)); h3_load(unit, dir, bo0, I, LF, Qh, Vh, lq, vw); }
#endif
        const int cs = dir ? (31 - c) : c; const size_t su = ((size_t)((n * 4 + h) * 2 + dir)) * 32 + cs;
        bf16x8 sfr[4];
#pragma unroll
        for (int ks = 0; ks < 4; ++ks) sfr[ks] = *(const bf16x8*)(ST + (su * 128 + 16 * wid + fr) * 128 + 32 * ks + 8 * fq);
        unsigned ghw[8];
#pragma unroll
        for (int j = 0; j < 8; ++j) ghw[j] = 0u;
        if (dir == 1) { unsigned eo = (unsigned)(16 * wid + fr) * 2u; asm volatile("" : "+v"(eo));
            const bf16_t* ghb = Gh + ((size_t)n * 2048 + 64 * c) * HGW + h * 128;
#pragma unroll
            for (int mb = 0; mb < 4; ++mb)
#pragma unroll
                for (int j = 0; j < 4; ++j) { const int p = 16 * mb + 4 * fq + j; const unsigned v = (unsigned)*(const bf16_t*)((const char*)ghb + ((unsigned)(p * (HGW * 2)) + eo));
                    if (j & 1) ghw[2 * mb + (j >> 1)] |= v << 16; else ghw[2 * mb + (j >> 1)] = v; } }
        float beta[16];
        float run = 0.f;
#pragma unroll
        for (int j = 0; j < 16; ++j) { run += bflo(lq[j]); beta[j] = run; }
        Ts[I * 128 + d] = run;
        __syncthreads();
        const float T0 = Ts[d], T1 = Ts[128 + d], T2 = Ts[256 + d];
        const float rI = (I > 0 ? T0 : 0.f) + (I > 1 ? T1 : 0.f) + (I > 2 ? T2 : 0.f);
        const float TI = (I == 0) ? T0 : (I == 1) ? T1 : (I == 2) ? T2 : 0.f;
        const float TI1 = (I == 0) ? T1 : (I == 1) ? T2 : 0.f;
        const float TI2 = (I == 0) ? T2 : 0.f;
        const float e_rI = fexp(rI);
        const float E1 = fexp(TI), E2 = fexp(TI + TI1), E3 = fexp(TI + TI1 + TI2);
        const int vb0 = (I == 0) ? 0 : (I == 1) ? 16 : (I == 2) ? 48 : 96;
        const int vb1 = (I == 0) ? 16 : (I == 1) ? 48 : 96, vb2 = (I == 0) ? 48 : 96;
#pragma unroll
        for (int j = 0; j < 16; ++j) {
            const int t = 16 * I + j;
            const float eb = fexp(beta[j]); const float qe = bfhi(lq[j]) * eb;
            *(LAS unsigned short*)(qt + t * 272 + d * 2) = f2bf(qe);
            *(LAS unsigned short*)(qbL + t * 272 + d * 2) = f2bf(qe * e_rI);
            const float k = 1.f - fexp(bflo(lq[j]));
            const float kd = k * fexp(-beta[j]);
            *(LAS unsigned short*)(kv + (vb0 + t) * 272 + d * 2) = f2bf(kd);
            if (I < 3) *(LAS unsigned short*)(kv + (vb1 + t) * 272 + d * 2) = f2bf(kd * E1);
            if (I < 2) *(LAS unsigned short*)(kv + (vb2 + t) * 272 + d * 2) = f2bf(kd * E2);
            if (I < 1) *(LAS unsigned short*)(kv + (96 + t) * 272 + d * 2) = f2bf(kd * E3);
            if ((j & 3) == 3) __builtin_amdgcn_sched_barrier(0);
        }
        { u32x4 a; a.x = vw[0]; a.y = vw[1]; a.z = vw[2]; a.w = vw[3]; u32x4 bq; bq.x = vw[4]; bq.y = vw[5]; bq.z = vw[6]; bq.w = vw[7];
          *(LAS u32x4*)(vT + d * 144 + I * 32) = a; *(LAS u32x4*)(vT + d * 144 + I * 32 + 16) = bq; }
        __syncthreads();
        for (int blk = wid; blk < 10; blk += 8) {
            const int Ib = (blk < 1) ? 0 : (blk < 3) ? 1 : (blk < 6) ? 2 : 3;
            const int Jb = blk - ((Ib * (Ib + 1)) >> 1);
            const int vbI = (Ib == 0) ? 0 : (Ib == 1) ? 16 : (Ib == 2) ? 48 : 96;
            f32x4 sc = {0.f, 0.f, 0.f, 0.f};
#pragma unroll
            for (int ks = 0; ks < 4; ++ks) {
                const bf16x8 a = *(const LAS bf16x8*)(qt + (16 * Ib + fr) * 272 + (32 * ks + 8 * fq) * 2);
                const bf16x8 bb = *(const LAS bf16x8*)(kv + (vbI + 16 * Jb + fr) * 272 + (32 * ks + 8 * fq) * 2);
                sc = __builtin_amdgcn_mfma_f32_16x16x32_bf16(a, bb, sc, 0, 0, 0);
            }
#pragma unroll
            for (int j = 0; j < 4; ++j) { float v = sc[j]; if (Ib == Jb && fr > 4 * fq + j) v = 0.f;
                *(LAS unsigned short*)(P + (16 * Ib + 4 * fq + j) * 144 + (16 * Jb + fr) * 2) = f2bf(v); }
        }
        __syncthreads();
#pragma unroll
        for (int mb = 0; mb < 4; ++mb) {
            const int p = 16 * mb + fr; const int tr = dir ? (63 - p) : p;
#pragma unroll
            for (int ks = 0; ks < 4; ++ks) { const bf16x8 a = *(const LAS bf16x8*)(qbL + tr * 272 + (32 * ks + 8 * fq) * 2);
                acc[mb] = __builtin_amdgcn_mfma_f32_16x16x32_bf16(a, sfr[ks], acc[mb], 0, 0, 0); }
#pragma unroll
            for (int ks = 0; ks < 2; ++ks) { const bf16x8 a = *(const LAS bf16x8*)(P + tr * 144 + (32 * ks + 8 * fq) * 2);
                const bf16x8 bv = *(const LAS bf16x8*)(vT + (16 * wid + fr) * 144 + (32 * ks + 8 * fq) * 2);
                acc[mb] = __builtin_amdgcn_mfma_f32_16x16x32_bf16(a, bv, acc[mb], 0, 0, 0); }
            __builtin_amdgcn_sched_barrier(0);
        }
        __syncthreads();
        if (dir == 0) continue;
#pragma unroll
        for (int mb = 0; mb < 4; ++mb)
#pragma unroll
            for (int j = 0; j < 4; ++j) { float s = acc[mb][j] * acc[mb][j];
                s += __shfl_xor(s, 1); s += __shfl_xor(s, 2); s += __shfl_xor(s, 4); s += __shfl_xor(s, 8);
                if (fr == 0) red[wid * 64 + 16 * mb + 4 * fq + j] = s; }
        __syncthreads();
        if (tid < 64) { float t = 0.f;
#pragma unroll
            for (int w = 0; w < 8; ++w) t += red[w * 64 + tid];
            rsv[tid] = rsqrtf(t * (1.f / 128.f) + EPS); }
        __syncthreads();
        const int e = 16 * wid + fr; const float ge = hgain[e];
        unsigned eo = (unsigned)e * 2u; asm volatile("" : "+v"(eo));
        bf16_t* ymb = ymix + ((size_t)n * 2048 + 64 * c) * D + h * 128;
#pragma unroll
        for (int mb = 0; mb < 4; ++mb) {
#pragma unroll
            for (int j = 0; j < 4; ++j) { const int p = 16 * mb + 4 * fq + j;
                const unsigned gw2 = ghw[2 * mb + (j >> 1)]; const float y = acc[mb][j] * rsv[p] * ge * ((j & 1) ? bfhi(gw2) : bflo(gw2));
                *(bf16_t*)((char*)ymb + ((unsigned)(p * (D * 2)) + eo)) = f2bf(y); }
            acc[mb] = (f32x4){0.f, 0.f, 0.f, 0.f};
        }
    }
}

#ifdef DIAG
__device__ __forceinline__ void nan_check_bf16(const bf16_t* buf, size_t n, unsigned* flag) {
    const size_t gt = (size_t)blockIdx.x * 512 + otid(), GN = (size_t)gridDim.x * 512; unsigned bad = 0;
#pragma unroll 1
    for (size_t i = gt; i < n / 2; i += GN) { const unsigned w = ((const unsigned*)buf)[i]; if ((w & 0x7f80u) == 0x7f80u || (w & 0x7f800000u) == 0x7f800000u) bad = 1; }
    if (bad) atomicOr(flag, 1u);
}
__device__ __forceinline__ void nan_check_f32(const float* buf, size_t n, unsigned* flag) {
    const size_t gt = (size_t)blockIdx.x * 512 + otid(), GN = (size_t)gridDim.x * 512; unsigned bad = 0;
#pragma unroll 1
    for (size_t i = gt; i < n; i += GN) { const unsigned w = __float_as_uint(buf[i]); if ((w & 0x7f800000u) == 0x7f800000u) bad = 1; }
    if (bad) atomicOr(flag, 1u);
}
#define DCHK_BF(buf, n, slot) nan_check_bf16(buf, n, DIAGW + (slot))
#define DCHK_F(buf, n, slot) nan_check_f32(buf, n, DIAGW + (slot))
#else
#define DCHK_BF(buf, n, slot)
#define DCHK_F(buf, n, slot)
#endif

#ifndef STOP_AT
#define STOP_AT 0
#endif
__device__ __forceinline__ void dump_bf16(const bf16_t* buf, float* out) {
    const size_t gt = (size_t)blockIdx.x * 512 + otid(), GN = (size_t)gridDim.x * 512;
#pragma unroll 1
    for (size_t i = gt; i < (size_t)M * D; i += GN) {
#ifdef DUMP_NANFLAG
        const unsigned short w = buf[i]; out[i] = ((w & 0x7f80u) == 0x7f80u) ? 1000.f : 0.f;
#else
        out[i] = bf2f(buf[i]);
#endif
    }
}
#ifndef STOP_L
#define STOP_L 0
#endif
#define STOPK(k, buf) if (a.stop_at == (k) && l == a.stop_l) { dump_bf16(buf, a.out); return; }
#define XB_TMO      128
#define XB_XCNT(j)  (256  + 64 * (j))
#define XB_XSUB(j)  (1280 + 64 * (j))
#define XB_XGEN(j)  (2304 + 64 * (j))
#define XB_TOP      3328
#define XB_TOPGEN   3392
#define XCD_BAR_WORDS 3456
#define XB_SPIN_CAP (1u << 18)

__device__ __forceinline__ unsigned xb_ld(unsigned* p)              { return __hip_atomic_load(p, __ATOMIC_RELAXED, __HIP_MEMORY_SCOPE_AGENT); }
__device__ __forceinline__ unsigned xb_add(unsigned* p, unsigned v) { return __hip_atomic_fetch_add(p, v, __ATOMIC_RELAXED, __HIP_MEMORY_SCOPE_AGENT); }
__device__ __forceinline__ unsigned xb_xcc_id() { return (unsigned)__builtin_amdgcn_s_getreg((3 << 11) | 20) & 0xFu; }
#define XB_SPIN(cond, bar) do { unsigned _sp = 0; while (cond) { __builtin_amdgcn_s_sleep(1); \
    if ((++_sp & 255u) == 0u) { if (xb_ld(&(bar)[XB_TMO])) break; if (_sp > XB_SPIN_CAP) { atomicAdd(&(bar)[XB_TMO], 1u); break; } } } } while (0)

struct XcdBarrier {
    unsigned* bar; unsigned x;
    volatile LAS unsigned* st;
};

__device__ __forceinline__ XcdBarrier xcd_barrier_post(unsigned* bar, volatile LAS unsigned* st) {
    XcdBarrier b; b.bar = bar; b.x = xb_xcc_id(); b.st = st;
    if (threadIdx.x == 0) (void)xb_add(&bar[XB_XCNT(b.x)], 1u);
    return b;
}
__device__ __forceinline__ void xcd_barrier_complete(unsigned* bar, unsigned x, unsigned& nloc, unsigned& nx) {
    const unsigned G = gridDim.x * gridDim.y * gridDim.z;
    unsigned sum, cnt, mine, sp = 0u;
    for (;;) {
        sum = 0u; cnt = 0u; mine = 0u;
#pragma unroll
        for (unsigned j = 0; j < 16; ++j) { const unsigned c = xb_ld(&bar[XB_XCNT(j)]); sum += c; cnt += (c > 0u) ? 1u : 0u; mine = (j == x) ? c : mine; }
        if (sum == G) break;
        __builtin_amdgcn_s_sleep(1);
        if ((++sp & 255u) == 0u) { if (xb_ld(&bar[XB_TMO])) break; if (sp > XB_SPIN_CAP) { atomicAdd(&bar[XB_TMO], 1u); break; } }
    }
    nloc = mine > 0u ? mine : 1u; nx = cnt > 0u ? cnt : 1u;
}

__device__ __forceinline__ void xcd_barrier(const XcdBarrier& b) {
    asm volatile("s_waitcnt vmcnt(0)" ::: "memory");
    __syncthreads();
    if (threadIdx.x == 0) {
        unsigned* bar = b.bar;
        __builtin_amdgcn_s_waitcnt(0);
        unsigned nloc = b.st[0], nx = b.st[1];
        if (nloc == 0u) { xcd_barrier_complete(bar, b.x, nloc, nx); b.st[0] = nloc; b.st[1] = nx; }
        const unsigned old = xb_add(&bar[XB_XSUB(b.x)], 1u);
        const unsigned gen = old / nloc;
        if (old + 1u == (gen + 1u) * nloc) {
            __builtin_amdgcn_fence(__ATOMIC_RELEASE, "agent");
            asm volatile("s_waitcnt vmcnt(0)" ::: "memory");
            const unsigned og = xb_add(&bar[XB_TOP], 1u);
            const unsigned tg = og / nx;
            if (og + 1u == (tg + 1u) * nx) xb_add(&bar[XB_TOPGEN], 1u);
            else XB_SPIN(xb_ld(&bar[XB_TOPGEN]) == tg, bar);
            __builtin_amdgcn_fence(__ATOMIC_ACQUIRE, "agent");
            xb_add(&bar[XB_XGEN(b.x)], 1u);
            asm volatile("s_waitcnt vmcnt(0)" ::: "memory");
        } else {
            XB_SPIN(xb_ld(&bar[XB_XGEN(b.x)]) == gen, bar);
            __builtin_amdgcn_fence(__ATOMIC_ACQUIRE, "agent");
            asm volatile("s_waitcnt vmcnt(0)" ::: "memory");
        }
    }
    __syncthreads();
}

__global__ void __launch_bounds__(512, 2) hybrid_fwd(Args a) {
    extern __shared__ __attribute__((aligned(16))) unsigned char lds_raw[];
    LAS unsigned char* lds = (LAS unsigned char*)lds_raw;
    cg::grid_group grid = cg::this_grid();
    { volatile LAS unsigned* st0 = (volatile LAS unsigned*)(lds + 140000); if (threadIdx.x < 2) st0[threadIdx.x] = 0u; __syncthreads(); }
    const XcdBarrier xbar = xcd_barrier_post((unsigned*)(a.ws + WS_CTL + 524288), (volatile LAS unsigned*)(lds + 140000));
#define GSYNC() xcd_barrier(xbar)
    unsigned char* ws = a.ws;
    float* COND = (float*)(ws + WS_CTL + CT_COND); float* ROWSS = (float*)(ws + WS_RSP); float* LBT = (float*)(ws + WS_CTL + CT_LBT);
    bf16_t* WINT = (bf16_t*)(ws + WS_WIN); bf16_t* WOUTT = (bf16_t*)(ws + WS_WOUT); bf16_t* W1T = (bf16_t*)(ws + WS_W1); bf16_t* W2T = (bf16_t*)(ws + WS_W2);
    bf16_t* ABUF = (bf16_t*)(ws + WS_ABUF);
    bf16_t* QH = (bf16_t*)(ws + WS_QH); bf16_t* LF = (bf16_t*)(ws + WS_LF); bf16_t* VH = (bf16_t*)(ws + WS_VH); bf16_t* GH = (bf16_t*)(ws + WS_GH);
    bf16_t* AQ = (bf16_t*)(ws + WS_AQ); bf16_t* AK = (bf16_t*)(ws + WS_AK); bf16_t* VT = (bf16_t*)(ws + WS_VT);
    bf16_t* ST = (bf16_t*)(ws + WS_ST); float* GG = (float*)(ws + WS_G);
    unsigned* DIAGW = (unsigned*)(ws + WS_CTL + 500000); (void)DIAGW;
    bf16_t* YRAW1 = (bf16_t*)(ws + WS_YRAW1); bf16_t* UB = (bf16_t*)(ws + WS_U); bf16_t* YRAW2 = (bf16_t*)(ws + WS_YRAW2);

    {
        const int tid = otid(), lane = tid & 63, wave = tid >> 6;
        LAS float* sc = (LAS float*)lds;
        LAS float* part = (LAS float*)(lds + 32768);
        if ((int)blockIdx.x < 192) {
            for (int i = tid; i < 8 * D; i += 512) sc[i] = siluf(a.c[i]);
            __syncthreads();
        }
        for (int ib = blockIdx.x; ib < 192; ib += gridDim.x) {
            const int col = tid & 31, kg = tid >> 5, j = ib * 32 + col;
            float ac[8];
#pragma unroll
            for (int b = 0; b < 8; ++b) ac[b] = 0.f;
#pragma unroll 8
            for (int kk = 0; kk < 64; ++kk) { const int k = kg * 64 + kk; const float w = a.w_ada[(size_t)k * NMOD6 + j];
#pragma unroll
                for (int b = 0; b < 8; ++b) ac[b] += sc[b * D + k] * w; }
#pragma unroll
            for (int b = 0; b < 8; ++b) part[(kg * 8 + b) * 32 + col] = ac[b];
            __syncthreads();
            if (tid < 256) { const int b = tid >> 5; float t = 0.f;
#pragma unroll
                for (int g = 0; g < 16; ++g) t += part[(g * 8 + b) * 32 + col];
                COND[b * NMOD6 + ib * 32 + col] = t; }
            __syncthreads();
        }
        if (blockIdx.x == gridDim.x - 1) { const float l0 = a.lb_logits[tid], l1 = a.lb_logits[HGW + tid]; LBT[tid] = 0.f; LBT[HGW + tid] = 1.f / (1.f + __expf(l0 - l1)); }
        LAS float* scr = (LAS float*)(lds + 49152 + wave * 8448);
        const int gw = blockIdx.x * 8 + wave, NGW = gridDim.x * 8;
        constexpr int I_IN = (D / 64) * (INC / 32), I_OUT = (D / 64) * (D / 32), I_1 = (D / 64) * (FF / 32), I_2 = (FF / 64) * (D / 32), I_L = I_IN + I_OUT + I_1 + I_2;
        for (int it = gw; it < 2 * I_L; it += NGW) {
            const int l = it / I_L; int r = it % I_L;
            if (r < I_IN) { transpose_item(a.w_in + (size_t)l * D * INC, D, INC, WINT + (size_t)l * INC * D, scr, r, lane); continue; } r -= I_IN;
            if (r < I_OUT) { transpose_item(a.w_out + (size_t)l * D * D, D, D, WOUTT + (size_t)l * D * D, scr, r, lane); continue; } r -= I_OUT;
            if (r < I_1) { transpose_item(a.w_ff1 + (size_t)l * D * FF, D, FF, W1T + (size_t)l * FF * D, scr, r, lane); continue; } r -= I_1;
            transpose_item(a.w_ff2 + (size_t)l * FF * D, FF, D, W2T + (size_t)l * D * FF, scr, r, lane);
        }
    }
    grid.sync();

    row_phase(a.x, nullptr, nullptr, nullptr, nullptr, COND, nullptr, 0, ABUF, a.pre_mix, a.ada_bias, 0, 1);
    GSYNC();
    { const int l = 0; STOPK(1, ABUF) }
    DCHK_BF(ABUF, (size_t)M * D, 0); DCHK_BF(WINT, (size_t)2 * INC * D, 1); DCHK_BF(W1T, (size_t)2 * FF * D, 1); DCHK_BF(W2T, (size_t)2 * FF * D, 1); DCHK_BF(WOUTT, (size_t)2 * D * D, 1);
#pragma unroll 1
    for (int l = 0; l < 2; ++l) {
        const float* biasl = a.ada_bias + (size_t)l * NMOD6;
        STOPK(11, ABUF)
        { pg8::Gemm g{ABUF, WINT + (size_t)l * INC * D, M, INC, D}; pg8::StaticOrder S; S.init(M, INC, (int)gridDim.x, (int)blockIdx.x);
          EpiIn E{QH, LF, VH, GH, AQ, AK, VT, LBT + l * HGW};
#ifndef SKIP_G1
#ifdef REP_GEMM
          pg8::gemm_phase<EpiIn, pg8::StaticOrder, true, true>(lds, g, S, E);
#endif
          pg8::gemm_phase<EpiIn, pg8::StaticOrder, true, true>(lds, g, S, E);
#endif
        }
        GSYNC();
        STOPK(2, LF) STOPK(12, QH) STOPK(13, AQ)
        DCHK_BF(QH, (size_t)M * HGW, 2 + 16 * l); DCHK_BF(LF, (size_t)2 * M * HGW, 3 + 16 * l); DCHK_BF(VH, (size_t)M * HGW, 4 + 16 * l); DCHK_BF(GH, (size_t)M * HGW, 4 + 16 * l); DCHK_BF(AQ, (size_t)M * HGW, 5 + 16 * l); DCHK_BF(AK, (size_t)M * 128, 5 + 16 * l); DCHK_BF(VT, (size_t)M * 128, 5 + 16 * l);
#ifdef REP_MIX
        attn_prep(AQ, AK, a.q_gain + l * 64, a.k_gain + l * 64);
#pragma unroll 1
        for (int rep = 0; rep < 2; ++rep) {
#define SKIP_PREP
#endif
#ifndef SKIP_H1
        h1_phase(lds, LF, VH, ST, GG);
#endif
#ifdef REP_H1
        h1_phase(lds, LF, VH, ST, GG);
#endif
#ifndef SKIP_PREP
        attn_prep(AQ, AK, a.q_gain + l * 64, a.k_gain + l * 64);
#endif
        GSYNC();
        STOPK(3, ST) STOPK(14, AQ)
        DCHK_BF(ST, (size_t)2048 * 128 * 128, 6 + 16 * l); DCHK_F(GG, (size_t)2048 * 128, 6 + 16 * l); DCHK_BF(AQ, (size_t)M * HGW, 7 + 16 * l); DCHK_BF(AK, (size_t)M * 128, 7 + 16 * l);
#ifndef SKIP_H2
        h2_phase(ST, GG);
#endif
#ifndef SKIP_ATT
        attn_phase(lds, AQ, AK, VT, ABUF, a.ao_gain + l * 64, ST, GG, a.q_gain + l * 64, a.k_gain + l * 64);
#endif
#ifdef REP_ATT
        attn_phase(lds, AQ, AK, VT, ABUF, a.ao_gain + l * 64, ST, GG, a.q_gain + l * 64, a.k_gain + l * 64);
#endif
        GSYNC();
        STOPK(4, ST) STOPK(15, ABUF)
        DCHK_BF(ST, (size_t)2048 * 128 * 128, 8 + 16 * l); DCHK_BF(ABUF, (size_t)M * D, 9 + 16 * l);
#ifndef SKIP_H3
        h3_phase(lds, LF, QH, VH, GH, ST, a.hg_gain + l * 128, ABUF);
#endif
#ifdef REP_H3
        h3_phase(lds, LF, QH, VH, GH, ST, a.hg_gain + l * 128, ABUF);
#endif
        GSYNC();
        STOPK(5, ABUF)
        DCHK_BF(ABUF, (size_t)M * D, 10 + 16 * l);
#ifdef REP_MIX
        }
#endif
        { pg8::Gemm g{ABUF, WOUTT + (size_t)l * D * D, M, D, D}; pg8::StaticOrder S; S.init(M, D, (int)gridDim.x, (int)blockIdx.x);
          EpiRaw E{YRAW1, ROWSS};
#ifndef SKIP_G2
#ifdef REP_GEMM
          pg8::gemm_phase<EpiRaw, pg8::StaticOrder, true, true>(lds, g, S, E);
#endif
          pg8::gemm_phase<EpiRaw, pg8::StaticOrder, true, true>(lds, g, S, E);
#endif
        }
        GSYNC();
        STOPK(6, YRAW1)
        DCHK_BF(YRAW1, (size_t)M * D, 11 + 16 * l);
        row_phase(l == 0 ? a.x : a.out, a.out, YRAW1, ROWSS, a.post_mix + l * D, COND, biasl, 2, ABUF, a.pre_ff + l * D, biasl, 3, 4);
        GSYNC();
        if (a.stop_at == 7 && l == a.stop_l) return;
        DCHK_F(a.out, (size_t)M * D, 12 + 16 * l); DCHK_BF(ABUF, (size_t)M * D, 12 + 16 * l);
        { pg8::Gemm g{ABUF, W1T + (size_t)l * FF * D, M, FF, D}; pg8::StaticOrder S; S.init(M, FF, (int)gridDim.x, (int)blockIdx.x);
          EpiRelu2 E{UB};
#ifndef SKIP_G3
#ifdef REP_GEMM
          pg8::gemm_phase<EpiRelu2, pg8::StaticOrder, true, true>(lds, g, S, E);
#endif
          pg8::gemm_phase<EpiRelu2, pg8::StaticOrder, true, true>(lds, g, S, E);
#endif
        }
        GSYNC();
        STOPK(8, UB)
        DCHK_BF(UB, (size_t)M * FF, 13 + 16 * l);
        { pg8::Gemm g{UB, W2T + (size_t)l * D * FF, M, D, FF}; pg8::StaticOrder S; S.init(M, D, (int)gridDim.x, (int)blockIdx.x);
          EpiRaw E{YRAW2, ROWSS};
#ifndef SKIP_G4
#ifdef REP_GEMM
          pg8::gemm_phase<EpiRaw, pg8::StaticOrder, true, true>(lds, g, S, E);
#endif
          pg8::gemm_phase<EpiRaw, pg8::StaticOrder, true, true>(lds, g, S, E);
#endif
        }
        GSYNC();
        STOPK(9, YRAW2)
        DCHK_BF(YRAW2, (size_t)M * D, 14 + 16 * l);
#ifdef HDEBUG
        row_phase<true>
#else
        row_phase<false>
#endif
            (a.out, a.out, YRAW2, ROWSS, a.post_ff + l * D, COND, biasl, 5, l == 0 ? ABUF : nullptr, a.pre_mix + D, a.ada_bias + NMOD6, 0, 1);
        if (a.stop_at == 10 && l == a.stop_l) return;
        if (l == 0) GSYNC();
    }
#ifdef DIAG
    GSYNC();
    DCHK_F(a.out, (size_t)M * D, 31);
    GSYNC();
    { int first = -1; for (int k = 0; k < 32; ++k) if (first < 0 && DIAGW[k]) first = k;
      if (first >= 0) { const size_t gt = (size_t)blockIdx.x * 512 + otid(), GN = (size_t)gridDim.x * 512;
          for (size_t i = gt; i < (size_t)M * D; i += GN) a.out[i] = (i == 0) ? 1000.f * (float)(first + 1) : 0.f; } }
#endif
}

extern "C" void kernel_launch(void* const* d_in, const int* in_sizes, int n_in, void* d_out, int out_size, void* d_ws, size_t ws_size, hipStream_t stream) {
    static int grid = 0;
    if (grid == 0) {
        if (n_in != 17 || in_sizes[0] != M * D || out_size != M * D || ws_size < WS_END) { fprintf(stderr, "kernel_launch: unexpected shapes (n_in %d, in0 %d, out %d, ws %zu)\n", n_in, n_in > 0 ? in_sizes[0] : -1, out_size, ws_size); grid = -1; return; }
        int dev = 0, cus = 0, per_cu = 0;
        if (hipGetDevice(&dev) != hipSuccess || hipDeviceGetAttribute(&cus, hipDeviceAttributeMultiprocessorCount, dev) != hipSuccess) { grid = -1; return; }
        if (hipFuncSetAttribute((const void*)hybrid_fwd, hipFuncAttributeMaxDynamicSharedMemorySize, LDS_BYTES) != hipSuccess) { fprintf(stderr, "hipFuncSetAttribute failed\n"); grid = -1; return; }
        if (hipOccupancyMaxActiveBlocksPerMultiprocessor(&per_cu, (const void*)hybrid_fwd, 512, LDS_BYTES) != hipSuccess || per_cu < 1) { fprintf(stderr, "occupancy query: %d\n", per_cu); (void)hipGetLastError(); per_cu = 1; }
        grid = cus * 1;
    }
    if (grid < 0) return;
    if (hipMemsetAsync((char*)d_ws + WS_CTL + 524288, 0, 16384, stream) != hipSuccess) { fprintf(stderr, "memset failed\n"); return; }
    Args a{};
    a.x = (const float*)d_in[0]; a.c = (const float*)d_in[1]; a.w_ada = (const float*)d_in[2]; a.ada_bias = (const float*)d_in[3]; a.lb_logits = (const float*)d_in[4];
    a.pre_mix = (const float*)d_in[5]; a.post_mix = (const float*)d_in[6]; a.w_in = (const float*)d_in[7]; a.w_out = (const float*)d_in[8]; a.hg_gain = (const float*)d_in[9];
    a.q_gain = (const float*)d_in[10]; a.k_gain = (const float*)d_in[11]; a.ao_gain = (const float*)d_in[12]; a.pre_ff = (const float*)d_in[13]; a.post_ff = (const float*)d_in[14];
    a.w_ff1 = (const float*)d_in[15]; a.w_ff2 = (const float*)d_in[16];
    a.out = (float*)d_out; a.ws = (unsigned char*)d_ws; a.stop_at = STOP_AT; a.stop_l = STOP_L;
    void* args[] = {&a};
    hipError_t e = hipLaunchCooperativeKernel((const void*)hybrid_fwd, dim3(grid), dim3(512), args, LDS_BYTES, stream);
    if (e != hipSuccess) fprintf(stderr, "cooperative launch failed: %s (grid %d)\n", hipGetErrorString(e), grid);
}
```

```cpp
#include <hip/hip_runtime.h>
#include <hip/hip_cooperative_groups.h>
#include <cstdio>
#include <cstdint>
namespace cg = cooperative_groups;
namespace pg8 {
#define PG8_LAS __attribute__((address_space(3)))
typedef unsigned short bf16_t;
typedef short bf16x8 __attribute__((ext_vector_type(8)));
typedef float f32x4 __attribute__((ext_vector_type(4)));
typedef unsigned u32x4 __attribute__((ext_vector_type(4)));
constexpr int BM = 256, BK = 64, HALF = 128, HTB = HALF * BK * 2  , STAGE_BYTES = 8 * HTB, NXCD = 8, WGM = 8;

__host__ __device__ __forceinline__ int lds_byte(int r, int c) { const int st = (r >> 4) * 2 + (c >> 5), rr = r & 15, cc = c & 31, ob = rr * 64 + cc * 2; return st * 1024 + (ob ^ (((ob >> 9) & 1) << 5)); }
__host__ __device__ __forceinline__ void stage_rc(int b, int& R, int& C) { const int st = b / 1024, sb = b % 1024, swz = sb ^ (((sb >> 9) & 1) << 5); R = (st >> 1) * 16 + swz / 64; C = (st & 1) * 32 + (swz % 64) / 2; }
__host__ __device__ __forceinline__ int perm32(int rho) { const int n = rho >> 4, i = rho & 15; return 8 * (i >> 2) + 4 * n + (i & 3); }

struct Unit { int pm, pn; };
struct Gemm { const bf16_t* A; const bf16_t* Bt; int M, N, K; };

struct StaticOrder {
    int nM, nN, nwg, G, c;
    __host__ __device__ void init(int M, int N, int G_, int c_) { nM = M / BM; nN = N / BM; nwg = nM * nN; G = G_; c = c_; }
    __host__ __device__ bool next(int i, Unit& u) const {
        const long L = (long)i * G + c; if (L >= nwg) return false;
        int wgid = (int)L; { const int q = nwg / NXCD, r = nwg % NXCD, xcd = wgid % NXCD, off = wgid / NXCD; wgid = (xcd < r ? xcd * (q + 1) : r * (q + 1) + (xcd - r) * q) + off; }
        const int nig = WGM * nN, gid = wgid / nig, fm = gid * WGM, gsz = (nM - fm) < WGM ? (nM - fm) : WGM;
        u.pm = fm + ((wgid % nig) % gsz); u.pn = (wgid % nig) / gsz; return true;
    }
    __device__ __forceinline__ void a_ready(const Unit&) const {}
    __device__ __forceinline__ void done(const Unit&) const {}
};

typedef float f32x2_cv __attribute__((ext_vector_type(2)));
typedef __bf16 bf16x2_cv __attribute__((ext_vector_type(2)));
__device__ __forceinline__ unsigned cvt_pk_bf16(float lo, float hi) { const f32x2_cv v = {lo, hi}; const bf16x2_cv b = __builtin_convertvector(v, bf16x2_cv); return __builtin_bit_cast(unsigned, b); }
template <class Epi, class Sched, bool ALIGN_EPI = false, bool SP2 = false>
__device__ __forceinline__ void gemm_phase(PG8_LAS unsigned char* lds, const Gemm g, const Sched& S, const Epi& E) {
    int tid = threadIdx.x; asm volatile("" : "+v"(tid)); const int wid = __builtin_amdgcn_readfirstlane(tid >> 6), lane = tid & 63, wr = wid >> 2, wc = wid & 3, fr = lane & 15, fq = lane >> 4;
    const int K = g.K, nt = K / BK;
    unsigned voffA[2], voffB[2];
#pragma unroll
    for (int i = 0; i < 2; ++i) { int R, C; stage_rc(tid * 16 + i * 8192, R, C); const int Rb = Epi::PERM ? ((R & ~31) + perm32(R & 31)) : R;
        voffA[i] = (unsigned)(R * K + C) * 2u; voffB[i] = (unsigned)(Rb * K + C) * 2u; }
    const size_t kstep = (size_t)(BK * 2);
    const size_t hstep = (size_t)HALF * K * 2;
    const size_t tstep = 2 * hstep;
    const unsigned ldsw = (unsigned)wid * 1024u;
    const int aoff = lds_byte(wr * 64 + fr, fq * 8), boff = lds_byte(wc * 32 + fr, fq * 8);
#define PG8_SA(b, h) (((b) * 2 + (h)) * HTB)
#define PG8_SB(b, h) ((4 + (b) * 2 + (h)) * HTB)
#define PG8_STAGE(bufoff, gbase, voff) do { _Pragma("unroll") for (int _i = 0; _i < 2; ++_i) \
        __builtin_amdgcn_global_load_lds((const unsigned*)((const char*)(gbase) + (voff)[_i]), (PG8_LAS unsigned*)(lds + (bufoff) + ldsw + _i * 8192), 16, 0, 0); } while (0)
#define PG8_LDA(dst, b, h) do { _Pragma("unroll") for (int m = 0; m < 4; ++m) _Pragma("unroll") for (int k = 0; k < 2; ++k) dst[m][k] = *(const PG8_LAS bf16x8*)(lds + PG8_SA(b, h) + aoff + m * 2048 + k * 1024); } while (0)
#define PG8_LDB(dst, b, h) do { _Pragma("unroll") for (int n = 0; n < 2; ++n) _Pragma("unroll") for (int k = 0; k < 2; ++k) dst[n][k] = *(const PG8_LAS bf16x8*)(lds + PG8_SB(b, h) + boff + n * 2048 + k * 1024); } while (0)
#define PG8_MMA(ai, bj, At, Bt) do { __builtin_amdgcn_s_setprio(1); _Pragma("unroll") for (int m = 0; m < 4; ++m) _Pragma("unroll") for (int n = 0; n < 2; ++n) _Pragma("unroll") for (int k = 0; k < 2; ++k) \
        acc[ai][bj][m][n] = __builtin_amdgcn_mfma_f32_16x16x32_bf16(Bt[n][k], At[m][k], acc[ai][bj][m][n], 0, 0, 0); __builtin_amdgcn_s_setprio(0); } while (0)
#define PG8_WAIT_V(n) asm volatile("s_waitcnt vmcnt(" #n ")" ::: "memory")
#define PG8_WAIT_L(n) asm volatile("s_waitcnt lgkmcnt(" #n ")" ::: "memory")
#define PG8_BAR __builtin_amdgcn_s_barrier()
#define PG8_SCHED __builtin_amdgcn_sched_barrier(0)
    Unit cur, nxt; int ui = 0;
    if (!S.next(0, cur)) return;
    f32x4 acc[2][2][4][2];
#pragma unroll
    for (int a = 0; a < 2; ++a)
#pragma unroll
        for (int b = 0; b < 2; ++b)
#pragma unroll
            for (int m = 0; m < 4; ++m)
#pragma unroll
                for (int n = 0; n < 2; ++n) acc[a][b][m][n] = (f32x4){0.f, 0.f, 0.f, 0.f};
    bf16x8 At[4][2], B0[2][2], B1[2][2];
    const char* cA = (const char*)g.A + (size_t)cur.pm * tstep; const char* cB = (const char*)g.Bt + (size_t)cur.pn * tstep;
    S.a_ready(cur);
    if constexpr (SP2) {
        PG8_STAGE(PG8_SB(0, 0), cB, voffB); PG8_STAGE(PG8_SB(0, 1), cB + hstep, voffB); PG8_STAGE(PG8_SA(0, 0), cA, voffA); PG8_STAGE(PG8_SA(0, 1), cA + hstep, voffA);
        if (wr == 1) PG8_BAR;
        PG8_WAIT_V(2); PG8_BAR;
        PG8_STAGE(PG8_SB(1, 0), cB + kstep, voffB); PG8_STAGE(PG8_SA(1, 0), cA + kstep, voffA); PG8_STAGE(PG8_SB(1, 1), cB + hstep + kstep, voffB);
        PG8_WAIT_V(6); PG8_BAR;
    } else {
        PG8_STAGE(PG8_SB(0, 0), cB, voffB); PG8_STAGE(PG8_SA(0, 0), cA, voffA); PG8_STAGE(PG8_SB(0, 1), cB + hstep, voffB); PG8_STAGE(PG8_SA(0, 1), cA + hstep, voffA);
        if (wr == 1) PG8_BAR;
        PG8_WAIT_V(4); PG8_BAR;
        PG8_STAGE(PG8_SB(1, 0), cB + kstep, voffB); PG8_STAGE(PG8_SA(1, 0), cA + kstep, voffA); PG8_STAGE(PG8_SB(1, 1), cB + hstep + kstep, voffB);
        PG8_WAIT_V(6); PG8_BAR;
    }
    for (;;) {
        const bool has_next = S.next(ui + 1, nxt);
        const char* nA = has_next ? (const char*)g.A + (size_t)nxt.pm * tstep : cA; const char* nB = has_next ? (const char*)g.Bt + (size_t)nxt.pn * tstep : cB;
        for (int t = 0; t < nt; t += 2) {
            const bool last = (t == nt - 2);
            const char* a1 = cA + (size_t)(t + 1) * kstep;
            const char* a2 = last ? nA : cA + (size_t)(t + 2) * kstep; const char* b2 = last ? nB : cB + (size_t)(t + 2) * kstep;
            const char* a3 = a2 + kstep; const char* b3 = b2 + kstep;
            if (last && has_next) S.a_ready(nxt);
            if constexpr (SP2) {
            PG8_LDB(B0, 0, 0); PG8_LDB(B1, 0, 1); PG8_SCHED; PG8_LDA(At, 0, 0); PG8_STAGE(PG8_SA(1, 1), a1 + hstep, voffA);
            PG8_WAIT_V(8); PG8_WAIT_L(0); PG8_BAR; PG8_MMA(0, 0, At, B0); PG8_MMA(0, 1, At, B1); PG8_BAR; PG8_SCHED;
            PG8_LDA(At, 0, 1); PG8_STAGE(PG8_SB(0, 0), b2, voffB); PG8_STAGE(PG8_SB(0, 1), b2 + hstep, voffB); PG8_STAGE(PG8_SA(0, 0), a2, voffA);
            PG8_WAIT_V(8); PG8_WAIT_L(0); PG8_BAR; PG8_MMA(1, 0, At, B0); PG8_MMA(1, 1, At, B1); PG8_BAR; PG8_SCHED;
            PG8_LDB(B0, 1, 0); PG8_LDB(B1, 1, 1); PG8_SCHED; PG8_LDA(At, 1, 0); PG8_STAGE(PG8_SA(0, 1), a2 + hstep, voffA);
            PG8_WAIT_V(8); PG8_WAIT_L(0); PG8_BAR; PG8_MMA(0, 0, At, B0); PG8_MMA(0, 1, At, B1); PG8_BAR; PG8_SCHED;
            PG8_LDA(At, 1, 1); PG8_STAGE(PG8_SB(1, 0), b3, voffB); PG8_STAGE(PG8_SB(1, 1), b3 + hstep, voffB); PG8_STAGE(PG8_SA(1, 0), a3, voffA);
            PG8_WAIT_V(8); PG8_WAIT_L(0); PG8_BAR; PG8_MMA(1, 0, At, B0); PG8_MMA(1, 1, At, B1); PG8_BAR; PG8_SCHED;
            } else {
            PG8_LDB(B0, 0, 0); PG8_SCHED; PG8_LDA(At, 0, 0); PG8_STAGE(PG8_SA(1, 1), a1 + hstep, voffA);
            PG8_WAIT_L(8); PG8_BAR; PG8_WAIT_L(0); PG8_MMA(0, 0, At, B0); PG8_BAR; PG8_SCHED;
            PG8_LDB(B1, 0, 1); PG8_STAGE(PG8_SB(0, 0), b2, voffB);
            PG8_BAR; PG8_WAIT_L(0); PG8_MMA(0, 1, At, B1); PG8_BAR;
            PG8_LDA(At, 0, 1); PG8_STAGE(PG8_SA(0, 0), a2, voffA);
            PG8_BAR; PG8_WAIT_L(0); PG8_MMA(1, 0, At, B0); PG8_BAR; PG8_SCHED;
            PG8_STAGE(PG8_SB(0, 1), b2 + hstep, voffB);
            PG8_WAIT_V(6); PG8_BAR; PG8_MMA(1, 1, At, B1); PG8_BAR;
            PG8_LDB(B0, 1, 0); PG8_SCHED; PG8_LDA(At, 1, 0); PG8_STAGE(PG8_SA(0, 1), a2 + hstep, voffA);
            PG8_WAIT_L(8); PG8_BAR; PG8_WAIT_L(0); PG8_MMA(0, 0, At, B0); PG8_BAR; PG8_SCHED;
            PG8_LDB(B1, 1, 1); PG8_STAGE(PG8_SB(1, 0), b3, voffB);
            PG8_BAR; PG8_WAIT_L(0); PG8_MMA(0, 1, At, B1); PG8_BAR;
            PG8_LDA(At, 1, 1); PG8_STAGE(PG8_SA(1, 0), a3, voffA);
            PG8_BAR; PG8_WAIT_L(0); PG8_MMA(1, 0, At, B0); PG8_BAR; PG8_SCHED;
            PG8_STAGE(PG8_SB(1, 1), b3 + hstep, voffB);
            PG8_WAIT_V(6); PG8_BAR; PG8_MMA(1, 1, At, B1); PG8_BAR;
            }
        }
        if constexpr (ALIGN_EPI) { if (wr == 0) PG8_BAR; }
        if constexpr (!Epi::AFTER_DRAIN) { E(acc, cur, wr, wc, fr, fq); S.done(cur); }
        if (!has_next) break;
#pragma unroll
        for (int a = 0; a < 2; ++a)
#pragma unroll
            for (int b = 0; b < 2; ++b)
#pragma unroll
                for (int m = 0; m < 4; ++m)
#pragma unroll
                    for (int n = 0; n < 2; ++n) acc[a][b][m][n] = (f32x4){0.f, 0.f, 0.f, 0.f};
        cur = nxt; cA = nA; cB = nB; ++ui;
        if constexpr (ALIGN_EPI) { if (wr == 1) PG8_BAR; }
    }
    PG8_WAIT_V(0);
    if constexpr (!ALIGN_EPI) { if (wr == 0) PG8_BAR; }
    PG8_BAR;
    if constexpr (Epi::AFTER_DRAIN) { E.fused(acc, cur, wr, wc, fr, fq, lds, wid, lane); S.done(cur); }
#undef PG8_SA
#undef PG8_SB
#undef PG8_STAGE
#undef PG8_LDA
#undef PG8_LDB
#undef PG8_MMA
#undef PG8_WAIT_V
#undef PG8_WAIT_L
#undef PG8_BAR
#undef PG8_SCHED
}
}

#define LAS __attribute__((address_space(3)))
typedef pg8::bf16_t bf16_t;
typedef pg8::bf16x8 bf16x8;
typedef pg8::f32x4 f32x4;
typedef pg8::u32x4 u32x4;
typedef float f32x16 __attribute__((ext_vector_type(16)));
typedef unsigned u32x2 __attribute__((ext_vector_type(2)));

constexpr int D = 1024, NB = 8, SEQ = 2048, M = NB * SEQ, FF = 4096, INC = 3328, HGW = 512, NMOD6 = 6 * D;
constexpr float EPS = 1e-6f;
constexpr size_t MiB = 1u << 20;
constexpr size_t WS_CTL = 0, CTL_BYTES = 1 * MiB;
constexpr size_t CT_COND = 0, CT_ROWSS = 196608, CT_LBT = 458752;
constexpr size_t WS_WIN = 1 * MiB, WS_WOUT = 14 * MiB, WS_W1 = 18 * MiB, WS_W2 = 34 * MiB;
constexpr size_t WS_ABUF = 50 * MiB;
constexpr size_t WS_QH = 82 * MiB, WS_LF = 98 * MiB, WS_VH = 130 * MiB, WS_GH = 146 * MiB, WS_AQ = 162 * MiB, WS_AK = 178 * MiB, WS_VT = 182 * MiB;
constexpr size_t WS_ST = 186 * MiB, WS_G = 250 * MiB, WS_RSP = 251 * MiB, WS_END = 252 * MiB;
constexpr size_t WS_YRAW1 = 82 * MiB, WS_U = 82 * MiB, WS_YRAW2 = 210 * MiB;
constexpr int LDS_BYTES = 147456;

__device__ __forceinline__ float bf2f(unsigned short h) { return __uint_as_float(((unsigned)h) << 16); }
__device__ __forceinline__ float bflo(unsigned w) { return __uint_as_float(w << 16); }
__device__ __forceinline__ float bfhi(unsigned w) { return __uint_as_float(w & 0xffff0000u); }
__device__ __forceinline__ unsigned pk2(float lo, float hi) { return pg8::cvt_pk_bf16(lo, hi); }
__device__ __forceinline__ unsigned short f2bf(float f) { return (unsigned short)(pg8::cvt_pk_bf16(f, 0.f) & 0xffffu); }
__device__ __forceinline__ float wave_sum(float v) {
#pragma unroll
    for (int o = 1; o < 64; o <<= 1) v += __shfl_xor(v, o);
    return v;
}
__device__ __forceinline__ int otid() { int t = threadIdx.x; asm volatile("" : "+v"(t)); return t; }
__device__ __forceinline__ float fexp(float x) { return __builtin_amdgcn_exp2f(x * 1.4426950408889634f); }
__device__ __forceinline__ float siluf(float x) { return x * __builtin_amdgcn_rcpf(1.f + fexp(-x)); }

struct EpiIn {
    static constexpr bool PERM = true, AFTER_DRAIN = false;
    bf16_t *Qh, *LF, *Vh, *Gh, *AQ, *AK, *VT; const float* lbt;
    __device__ __forceinline__ void operator()(const f32x4 (&acc)[2][2][4][2], const pg8::Unit& u, int wr, int wc, int fr, int fq) const {
        const int row0 = u.pm * 256 + wr * 64 + fr;
        const int pn = u.pn, grp = pn >> 1;
#pragma unroll
        for (int bj = 0; bj < 2; ++bj) {
            const int colt = (pn & 1) * 256 + bj * 128 + wc * 32 + 8 * fq;
            if (pn == 12) {
                const int cc = wc * 32 + 8 * fq;
                if (bj == 0) {
#pragma unroll
                    for (int ai = 0; ai < 2; ++ai)
#pragma unroll
                        for (int m = 0; m < 4; ++m) { const int row = row0 + ai * 128 + m * 16; const f32x4 v0 = acc[ai][bj][m][0], v1 = acc[ai][bj][m][1];
                            u32x4 w; w.x = pk2(v0[0], v0[1]); w.y = pk2(v0[2], v0[3]); w.z = pk2(v1[0], v1[1]); w.w = pk2(v1[2], v1[3]);
                            *(u32x4*)(AK + (size_t)row * 128 + cc) = w; }
                } else {
                    const int kvh = cc >> 6, d0 = cc & 63;
#pragma unroll
                    for (int ai = 0; ai < 2; ++ai)
#pragma unroll
                        for (int m = 0; m < 4; ++m) { const int row = row0 + ai * 128 + m * 16; const int b = row >> 11, s = row & 2047;
                            bf16_t* vp = VT + ((size_t)((b * 2 + kvh) * 64 + d0)) * 2048 + s;
#pragma unroll
                            for (int n = 0; n < 2; ++n)
#pragma unroll
                                for (int i = 0; i < 4; ++i) vp[(size_t)(4 * n + i) * 2048] = f2bf(acc[ai][bj][m][n][i]); }
                }
                continue;
            }
            bf16_t* dst; int mode;
            if (grp == 0) { dst = Qh; mode = 1; } else if (grp == 1) { dst = LF; mode = 2; } else if (grp == 2) { dst = LF + (size_t)M * HGW; mode = 2; }
            else if (grp == 3) { dst = Vh; mode = 0; } else if (grp == 4) { dst = Gh; mode = 1; } else { dst = AQ; mode = 0; }
            f32x4 lb0 = {0.f, 0.f, 0.f, 0.f}, lb1 = {0.f, 0.f, 0.f, 0.f};
            if (mode == 2) { lb0 = *(const f32x4*)(lbt + colt); lb1 = *(const f32x4*)(lbt + colt + 4); }
#pragma unroll
            for (int ai = 0; ai < 2; ++ai)
#pragma unroll
                for (int m = 0; m < 4; ++m) { const int row = row0 + ai * 128 + m * 16; f32x4 v0 = acc[ai][bj][m][0], v1 = acc[ai][bj][m][1];
                    if (mode == 1) {
#pragma unroll
                        for (int i = 0; i < 4; ++i) { v0[i] = siluf(v0[i]); v1[i] = siluf(v1[i]); }
                    } else if (mode == 2) {
#pragma unroll
                        for (int i = 0; i < 4; ++i) {
                            { const float z = v0[i], lb = lb0[i]; const float ls = fminf(z, 0.f) - __logf(1.f + fexp(-fabsf(z))); v0[i] = lb > 0.f ? __logf(lb + (1.f - lb) * fexp(ls)) : ls; }
                            { const float z = v1[i], lb = lb1[i]; const float ls = fminf(z, 0.f) - __logf(1.f + fexp(-fabsf(z))); v1[i] = lb > 0.f ? __logf(lb + (1.f - lb) * fexp(ls)) : ls; }
                        }
                    }
                    u32x4 w; w.x = pk2(v0[0], v0[1]); w.y = pk2(v0[2], v0[3]); w.z = pk2(v1[0], v1[1]); w.w = pk2(v1[2], v1[3]);
                    *(u32x4*)(dst + (size_t)row * HGW + colt) = w; }
        }
    }
};
struct EpiRaw {
    static constexpr bool PERM = true, AFTER_DRAIN = false;
    bf16_t* Y; float* rowss;
    __device__ __forceinline__ void operator()(const f32x4 (&acc)[2][2][4][2], const pg8::Unit& u, int wr, int wc, int fr, int fq) const {
        const int row0 = u.pm * 256 + wr * 64 + fr, col0 = u.pn * 256 + wc * 32 + 8 * fq;
#pragma unroll
        for (int ai = 0; ai < 2; ++ai)
#pragma unroll
            for (int m = 0; m < 4; ++m) { const int row = row0 + ai * 128 + m * 16; float s = 0.f;
#pragma unroll
                for (int bj = 0; bj < 2; ++bj) { const f32x4 v0 = acc[ai][bj][m][0], v1 = acc[ai][bj][m][1];
                    s += (v0[0] * v0[0] + v0[1] * v0[1]) + (v0[2] * v0[2] + v0[3] * v0[3]) + (v1[0] * v1[0] + v1[1] * v1[1]) + (v1[2] * v1[2] + v1[3] * v1[3]);
                    u32x4 w; w.x = pk2(v0[0], v0[1]); w.y = pk2(v0[2], v0[3]); w.z = pk2(v1[0], v1[1]); w.w = pk2(v1[2], v1[3]);
                    *(u32x4*)(Y + (size_t)row * D + col0 + bj * 128) = w; }
                s += __shfl_xor(s, 16); s += __shfl_xor(s, 32);
                if (fq == 0) rowss[(size_t)row * 16 + u.pn * 4 + wc] = s; }
    }
};
struct EpiRelu2 {
    static constexpr bool PERM = true, AFTER_DRAIN = false;
    bf16_t* U;
    __device__ __forceinline__ void operator()(const f32x4 (&acc)[2][2][4][2], const pg8::Unit& u, int wr, int wc, int fr, int fq) const {
        const int row0 = u.pm * 256 + wr * 64 + fr, col0 = u.pn * 256 + wc * 32 + 8 * fq;
#pragma unroll
        for (int ai = 0; ai < 2; ++ai)
#pragma unroll
            for (int m = 0; m < 4; ++m) { const int row = row0 + ai * 128 + m * 16;
#pragma unroll
                for (int bj = 0; bj < 2; ++bj) { f32x4 v0 = acc[ai][bj][m][0], v1 = acc[ai][bj][m][1];
#pragma unroll
                    for (int i = 0; i < 4; ++i) { const float a = fmaxf(v0[i], 0.f), b = fmaxf(v1[i], 0.f); v0[i] = a * a; v1[i] = b * b; }
                    u32x4 w; w.x = pk2(v0[0], v0[1]); w.y = pk2(v0[2], v0[3]); w.z = pk2(v1[0], v1[1]); w.w = pk2(v1[2], v1[3]);
                    *(u32x4*)(U + (size_t)row * FF + col0 + bj * 128) = w; } }
    }
};

__device__ __forceinline__ void transpose_item(const float* W, int K, int N, bf16_t* WT, LAS float* scr, int item, int lane) {
    const int nblk = N / 32, kb = item / nblk, nb = item % nblk, k0 = 64 * kb, n0 = 32 * nb;
#pragma unroll 8
    for (int i = 0; i < 32; ++i) { const int kk = 2 * i + (lane >> 5); scr[kk * 33 + (lane & 31)] = W[(size_t)(k0 + kk) * N + n0 + (lane & 31)]; }
    asm volatile("s_waitcnt lgkmcnt(0)" ::: "memory");
    const int c = lane & 7;
#pragma unroll
    for (int j = 0; j < 4; ++j) { const int n = (lane >> 3) + 8 * j; const LAS float* s = scr + (8 * c) * 33 + n;
        u32x4 o; o.x = pk2(s[0 * 33], s[1 * 33]); o.y = pk2(s[2 * 33], s[3 * 33]); o.z = pk2(s[4 * 33], s[5 * 33]); o.w = pk2(s[6 * 33], s[7 * 33]);
        *(u32x4*)(WT + (size_t)(n0 + n) * K + k0 + 8 * c) = o; }
    asm volatile("s_waitcnt lgkmcnt(0)" ::: "memory");
}

struct Args {
    const float *x, *c, *w_ada, *ada_bias, *lb_logits, *pre_mix, *post_mix, *w_in, *w_out, *hg_gain, *q_gain, *k_gain, *ao_gain, *pre_ff, *post_ff, *w_ff1, *w_ff2;
    float* out; unsigned char* ws; int stop_at, stop_l;
};

template <bool DBG = false>
__device__ __forceinline__ void row_phase(const float* xin, float* xout, const bf16_t* yraw, const float* rowss, const float* post, const float* cond, const float* biasg  , int gidx,
                                          bf16_t* hout, const float* pre, const float* biash  , int shidx, int scidx) {
    const int tid = otid(), lane = tid & 63, wave = tid >> 6;
    const int gw = blockIdx.x * 8 + wave, NGW = gridDim.x * 8;
    const int RPW = (M + NGW - 1) / NGW, rbeg = gw * RPW, rend = (rbeg + RPW < M) ? (rbeg + RPW) : M;
    int bcur = -1;
    f32x4 Gm[4], Am[4], Bm[4];
    f32x4 xn[4]; u32x2 yn[4]; f32x4 pn[4];
#pragma unroll
    for (int j = 0; j < 4; ++j) { xn[j] = (f32x4){0.f, 0.f, 0.f, 0.f}; yn[j] = (u32x2){0u, 0u}; pn[j] = (f32x4){0.f, 0.f, 0.f, 0.f}; Gm[j] = Am[j] = Bm[j] = (f32x4){0.f, 0.f, 0.f, 0.f}; }
#define RP_LOAD(rr) do { _Pragma("unroll") for (int j = 0; j < 4; ++j) { xn[j] = *(const f32x4*)(xin + (size_t)(rr) * D + 256 * j + 4 * lane); \
        if (yraw) { yn[j] = *(const u32x2*)(yraw + (size_t)(rr) * D + 256 * j + 4 * lane); pn[j] = *(const f32x4*)(rowss + (size_t)(rr) * 16 + 4 * j); } } } while (0)
    if (rbeg < rend) RP_LOAD(rbeg);
#pragma unroll 1
    for (int r = rbeg; r < rend; ++r) {
        f32x4 xv[4]; u32x2 yw[4]; f32x4 pv[4];
#pragma unroll
        for (int j = 0; j < 4; ++j) { xv[j] = xn[j]; yw[j] = yn[j]; pv[j] = pn[j]; }
        if (r + 1 < rend) RP_LOAD(r + 1);
        const int b = r >> 11;
        if (b != bcur) { bcur = b;
#pragma unroll
            for (int j = 0; j < 4; ++j) { const int c = 256 * j + 4 * lane;
                if (yraw) { const f32x4 pg = *(const f32x4*)(post + c); const f32x4 gc = *(const f32x4*)(cond + (size_t)b * NMOD6 + gidx * D + c), gb = *(const f32x4*)(biasg + gidx * D + c);
                    Gm[j] = (gc + gb) * pg; }
                if (hout) { const f32x4 pg = *(const f32x4*)(pre + c);
                    const f32x4 sc = *(const f32x4*)(cond + (size_t)b * NMOD6 + scidx * D + c), sb = *(const f32x4*)(biash + scidx * D + c);
                    const f32x4 sh = *(const f32x4*)(cond + (size_t)b * NMOD6 + shidx * D + c), hb = *(const f32x4*)(biash + shidx * D + c);
                    Am[j] = pg * (sc + sb + 1.f); Bm[j] = sh + hb; } } }
        if (yraw) {
            float ssum = 0.f;
#pragma unroll
            for (int q = 0; q < 4; ++q) ssum += (pv[q][0] + pv[q][1]) + (pv[q][2] + pv[q][3]);
            const float rs = rsqrtf(ssum * (1.f / D) + EPS);
#pragma unroll
            for (int j = 0; j < 4; ++j) { const int c = 256 * j + 4 * lane;
                xv[j][0] += Gm[j][0] * (bflo(yw[j].x) * rs); xv[j][1] += Gm[j][1] * (bfhi(yw[j].x) * rs);
                xv[j][2] += Gm[j][2] * (bflo(yw[j].y) * rs); xv[j][3] += Gm[j][3] * (bfhi(yw[j].y) * rs);
                *(f32x4*)(xout + (size_t)r * D + c) = xv[j]; }
        }
        if (hout) {
            float s = 0.f;
#pragma unroll
            for (int j = 0; j < 4; ++j) s += (xv[j][0] * xv[j][0] + xv[j][1] * xv[j][1]) + (xv[j][2] * xv[j][2] + xv[j][3] * xv[j][3]);
            const float rs2 = rsqrtf(wave_sum(s) * (1.f / D) + EPS);
#pragma unroll
            for (int j = 0; j < 4; ++j) { const int c = 256 * j + 4 * lane;
                float h[4];
#pragma unroll
                for (int i = 0; i < 4; ++i) h[i] = xv[j][i] * rs2 * Am[j][i] + Bm[j][i];
                u32x2 w; w.x = pk2(h[0], h[1]); w.y = pk2(h[2], h[3]);
                *(u32x2*)(hout + (size_t)r * D + c) = w; }
        }
    }
#undef RP_LOAD
}

__device__ __forceinline__ void attn_prep(bf16_t* AQ, bf16_t* AK, const float* qg, const float* kg) {
    const int tid = otid(), lane = tid & 63, wave = tid >> 6;
    const int gw = blockIdx.x * 8 + wave, NGW = gridDim.x * 8;
    const float invf = __builtin_amdgcn_exp2f(-(float)(lane & 15) * (13.287712379549449f / 16.f));
    const float qgl = qg[lane], kgl = kg[lane];
    constexpr float QSCALE = 0.125f * 1.4426950408889634f;
    unsigned short xn[10];
#pragma unroll
    for (int h = 0; h < 10; ++h) xn[h] = 0;
    if (gw < M) {
#pragma unroll
        for (int h = 0; h < 10; ++h) xn[h] = (h < 8) ? AQ[(size_t)gw * 512 + h * 64 + lane] : AK[(size_t)gw * 128 + (h - 8) * 64 + lane]; }
#pragma unroll 1
    for (int r = gw; r < M; r += NGW) {
        float x[10];
#pragma unroll
        for (int h = 0; h < 10; ++h) x[h] = bf2f(xn[h]);
        const int rn = r + NGW;
        if (rn < M) {
#pragma unroll
            for (int h = 0; h < 10; ++h) xn[h] = (h < 8) ? AQ[(size_t)rn * 512 + h * 64 + lane] : AK[(size_t)rn * 128 + (h - 8) * 64 + lane]; }
        const int s = r & 2047; const float pos = (float)((lane >> 5) ? (s & 63) : (s >> 6));
        const float ang = pos * invf; const float cs = __cosf(ang), sn = __sinf(ang);
#pragma unroll
        for (int h = 0; h < 10; ++h) {
            const float rs = rsqrtf(wave_sum(x[h] * x[h]) * (1.f / 64.f) + EPS);
            const float y = x[h] * rs * (h < 8 ? qgl : kgl);
            const float pr = __shfl_xor(y, 16);
            float o = (lane & 16) ? (y * cs + pr * sn) : (y * cs - pr * sn);
            if (h < 8) o *= QSCALE;
            x[h] = o;
        }
#pragma unroll
        for (int h = 0; h < 10; ++h) { bf16_t* p = (h < 8) ? (AQ + (size_t)r * 512 + h * 64 + lane) : (AK + (size_t)r * 128 + (h - 8) * 64 + lane); *p = f2bf(x[h]); }
    }
}

template <bool fixm>
__device__ __forceinline__ void attn_units(LAS unsigned char* lds, const bf16_t* QP, const bf16_t* KP, const bf16_t* VT, bf16_t* ymix, const float* og, bf16_t* UT, const float* G, const float sinit);
__device__ __forceinline__ void attn_phase(LAS unsigned char* lds, const bf16_t* QP, const bf16_t* KP, const bf16_t* VT, bf16_t* ymix, const float* og, bf16_t* UT, const float* G, const float* qg, const float* kg) {
    const int tid = otid(), wid = tid >> 6, lane = tid & 63, r32 = lane & 31, hi = lane >> 5;
    float mq = fabsf(qg[lane]), mk = fabsf(kg[lane]);
#pragma unroll
    for (int o = 1; o < 64; o <<= 1) { mq = fmaxf(mq, __shfl_xor(mq, o)); mk = fmaxf(mk, __shfl_xor(mk, o)); }
    const float B2 = 8.f * mq * mk * 1.4426950408889634f * 1.01f;
    const bool fixm0 = __builtin_amdgcn_readfirstlane((int)(B2 <= 40.f)) != 0;
    if (fixm0) attn_units<true>(lds, QP, KP, VT, ymix, og, UT, G, -B2); else attn_units<false>(lds, QP, KP, VT, ymix, og, UT, G, 0.f);
}
template <bool fixm>
__device__ __forceinline__ void attn_units(LAS unsigned char* lds, const bf16_t* QP, const bf16_t* KP, const bf16_t* VT, bf16_t* ymix, const float* og, bf16_t* UT, const float* G, const float sinit) {
    const int tid = otid(), wid = tid >> 6, lane = tid & 63, r32 = lane & 31, hi = lane >> 5;
    const int skey = tid >> 3, sch = tid & 7;
    const unsigned soff = skey * 144 + sch * 16;
    for (int unit = blockIdx.x; unit < 512; unit += gridDim.x) {
        const int b = unit >> 6, kvh = (unit >> 5) & 1, qb = unit & 31;
        const int head = kvh * 4 + (wid >> 1), tok0 = qb * 64 + (wid & 1) * 32;
        const bf16_t* qp = QP + (size_t)(b * 2048 + tok0 + r32) * 512 + head * 64 + 8 * hi;
        bf16x8 qf[4];
#pragma unroll
        for (int ks = 0; ks < 4; ++ks) qf[ks] = *(const bf16x8*)(qp + 16 * ks);
        const bf16_t* kg = KP + (size_t)(b * 2048 + skey) * 128 + kvh * 64 + 8 * sch;
        const bf16_t* vg = VT + ((size_t)((b * 2 + kvh) * 64 + skey)) * 2048 + 8 * sch;
        u32x4 kr = *(const u32x4*)kg, vr = *(const u32x4*)vg;
        *(LAS u32x4*)(lds + soff) = kr; *(LAS u32x4*)(lds + 18432 + soff) = vr;
        __syncthreads();
        f32x16 o0, o1;
#pragma unroll
        for (int i = 0; i < 16; ++i) { o0[i] = 0.f; o1[i] = 0.f; }
        float mrun = -INFINITY, lrun = 0.f;
        const int h2item = blockIdx.x * 512 + tid; const bool h2on = (unit == (int)blockIdx.x) && (h2item < 64 * 2048);
        bf16_t* hp = UT; const float* gp = G; float hS[8]; u32x4 huw = {0u, 0u, 0u, 0u}; f32x4 hg0 = {0.f, 0.f, 0.f, 0.f}, hg1 = {0.f, 0.f, 0.f, 0.f};
#pragma unroll
        for (int i = 0; i < 8; ++i) hS[i] = 0.f;
        if (h2on) { const int seq = h2item >> 11, rem = h2item & 2047, e = rem >> 4, d0 = (rem & 15) * 8;
            hp = UT + (((size_t)seq * 32) * 128 + e) * 128 + d0; gp = G + (size_t)seq * 32 * 128 + d0;
            huw = *(const u32x4*)hp; hg0 = *(const f32x4*)gp; hg1 = *(const f32x4*)(gp + 4); }
        for (int j = 0; j < 32; ++j) {
            if (j + 1 < 32) { kr = *(const u32x4*)(kg + (size_t)(j + 1) * 64 * 128); vr = *(const u32x4*)(vg + (j + 1) * 64); }
            const LAS unsigned char* kb = lds + (j & 1) * 9216; const LAS unsigned char* vb = lds + 18432 + (j & 1) * 9216;
            f32x16 s0, s1;
#pragma unroll
            for (int i = 0; i < 16; ++i) { s0[i] = sinit; s1[i] = sinit; }
#pragma unroll
            for (int ks = 0; ks < 4; ++ks) {
                const bf16x8 a0 = *(const LAS bf16x8*)(kb + r32 * 144 + (16 * ks + 8 * hi) * 2);
                const bf16x8 a1 = *(const LAS bf16x8*)(kb + (32 + r32) * 144 + (16 * ks + 8 * hi) * 2);
                s0 = __builtin_amdgcn_mfma_f32_32x32x16_bf16(a0, qf[ks], s0, 0, 0, 0);
                s1 = __builtin_amdgcn_mfma_f32_32x32x16_bf16(a1, qf[ks], s1, 0, 0, 0);
            }
            if (h2on) {
                u32x4 o; o.x = pk2(hS[0], hS[1]); o.y = pk2(hS[2], hS[3]); o.z = pk2(hS[4], hS[5]); o.w = pk2(hS[6], hS[7]);
                *(u32x4*)(hp + (size_t)j * 16384) = o;
                hS[0] = hg0[0] * hS[0] + bflo(huw.x); hS[1] = hg0[1] * hS[1] + bfhi(huw.x); hS[2] = hg0[2] * hS[2] + bflo(huw.y); hS[3] = hg0[3] * hS[3] + bfhi(huw.y);
                hS[4] = hg1[0] * hS[4] + bflo(huw.z); hS[5] = hg1[1] * hS[5] + bfhi(huw.z); hS[6] = hg1[2] * hS[6] + bflo(huw.w); hS[7] = hg1[3] * hS[7] + bfhi(huw.w);
                if (j + 1 < 32) { huw = *(const u32x4*)(hp + (size_t)(j + 1) * 16384); hg0 = *(const f32x4*)(gp + (j + 1) * 128); hg1 = *(const f32x4*)(gp + (j + 1) * 128 + 4); }
            }
            if (fixm) {
                float ps0 = 0.f, ps1 = 0.f;
#pragma unroll
                for (int i = 0; i < 16; ++i) { s0[i] = __builtin_amdgcn_exp2f(s0[i]); s1[i] = __builtin_amdgcn_exp2f(s1[i]); ps0 += s0[i]; ps1 += s1[i]; }
                lrun += ps0 + ps1;
            } else {
                float mx = fmaxf(s0[0], s1[0]);
#pragma unroll
                for (int i = 1; i < 16; ++i) mx = fmaxf(mx, fmaxf(s0[i], s1[i]));
                mx = fmaxf(mx, __shfl_xor(mx, 32));
                const float mnew = fmaxf(mrun, mx); const float alpha = __builtin_amdgcn_exp2f(mrun - mnew); mrun = mnew;
                float ps = 0.f;
#pragma unroll
                for (int i = 0; i < 16; ++i) { s0[i] = __builtin_amdgcn_exp2f(s0[i] - mnew); s1[i] = __builtin_amdgcn_exp2f(s1[i] - mnew); ps += s0[i] + s1[i]; }
                lrun = lrun * alpha + ps;
#pragma unroll
                for (int i = 0; i < 16; ++i) { o0[i] *= alpha; o1[i] *= alpha; }
            }
#pragma unroll
            for (int mb = 0; mb < 2; ++mb)
#pragma unroll
                for (int u = 0; u < 2; ++u) {
                    u32x4 pw;
                    if (mb == 0) { pw.x = pk2(s0[8 * u + 0], s0[8 * u + 1]); pw.y = pk2(s0[8 * u + 2], s0[8 * u + 3]); pw.z = pk2(s0[8 * u + 4], s0[8 * u + 5]); pw.w = pk2(s0[8 * u + 6], s0[8 * u + 7]); }
                    else         { pw.x = pk2(s1[8 * u + 0], s1[8 * u + 1]); pw.y = pk2(s1[8 * u + 2], s1[8 * u + 3]); pw.z = pk2(s1[8 * u + 4], s1[8 * u + 5]); pw.w = pk2(s1[8 * u + 6], s1[8 * u + 7]); }
                    const bf16x8 pb = __builtin_bit_cast(bf16x8, pw);
                    const int keybase = 32 * mb + 16 * u;
                    const u32x2 l0 = *(const LAS u32x2*)(vb + r32 * 144 + (keybase + 4 * hi) * 2), h0 = *(const LAS u32x2*)(vb + r32 * 144 + (keybase + 8 + 4 * hi) * 2);
                    const u32x2 l1 = *(const LAS u32x2*)(vb + (32 + r32) * 144 + (keybase + 4 * hi) * 2), h1 = *(const LAS u32x2*)(vb + (32 + r32) * 144 + (keybase + 8 + 4 * hi) * 2);
                    u32x4 a0w; a0w.x = l0.x; a0w.y = l0.y; a0w.z = h0.x; a0w.w = h0.y;
                    u32x4 a1w; a1w.x = l1.x; a1w.y = l1.y; a1w.z = h1.x; a1w.w = h1.y;
                    o0 = __builtin_amdgcn_mfma_f32_32x32x16_bf16(__builtin_bit_cast(bf16x8, a0w), pb, o0, 0, 0, 0);
                    o1 = __builtin_amdgcn_mfma_f32_32x32x16_bf16(__builtin_bit_cast(bf16x8, a1w), pb, o1, 0, 0, 0);
                }
            if (j + 1 < 32) { const unsigned nb = ((j + 1) & 1) * 9216; *(LAS u32x4*)(lds + nb + soff) = kr; *(LAS u32x4*)(lds + 18432 + nb + soff) = vr; }
            __syncthreads();
        }
        const float l = lrun + __shfl_xor(lrun, 32); const float inv = 1.f / l;
        float ss = 0.f;
#pragma unroll
        for (int i = 0; i < 16; ++i) { o0[i] *= inv; o1[i] *= inv; ss += o0[i] * o0[i] + o1[i] * o1[i]; }
        ss += __shfl_xor(ss, 32);
        const float rs = rsqrtf(ss * (1.f / 64.f) + EPS);
        bf16_t* yp = ymix + (size_t)(b * 2048 + tok0 + r32) * D + 512 + head * 64;
        f32x4 gv[2][4];
#pragma unroll
        for (int q4 = 0; q4 < 4; ++q4) { gv[0][q4] = *(const f32x4*)(og + 8 * q4 + 4 * hi); gv[1][q4] = *(const f32x4*)(og + 32 + 8 * q4 + 4 * hi); }
#pragma unroll
        for (int q4 = 0; q4 < 4; ++q4) {
            { const int d0 = 8 * q4 + 4 * hi; const f32x4 g = gv[0][q4];
              u32x2 w; w.x = pk2(o0[4 * q4 + 0] * rs * g[0], o0[4 * q4 + 1] * rs * g[1]); w.y = pk2(o0[4 * q4 + 2] * rs * g[2], o0[4 * q4 + 3] * rs * g[3]); *(u32x2*)(yp + d0) = w; }
            { const int d0 = 32 + 8 * q4 + 4 * hi; const f32x4 g = gv[1][q4];
              u32x2 w; w.x = pk2(o1[4 * q4 + 0] * rs * g[0], o1[4 * q4 + 1] * rs * g[1]); w.y = pk2(o1[4 * q4 + 2] * rs * g[2], o1[4 * q4 + 3] * rs * g[3]); *(u32x2*)(yp + d0) = w; }
        }
    }
}

__device__ __forceinline__ void h1_phase(LAS unsigned char* lds, const bf16_t* LF, const bf16_t* Vh, bf16_t* UT, float* G) {
    const int tid = otid(), wid = tid >> 6, lane = tid & 63, fr = lane & 15, fq = lane >> 4;
    const int d = tid & 127, I = tid >> 7;
    LAS float* Ts = (LAS float*)lds; LAS unsigned char* kdT = lds + 2048; LAS unsigned char* vT = lds + 2048 + 18432;
    for (int unit = blockIdx.x; unit < 2048; unit += gridDim.x) {
        const int c = unit & 31, dir = (unit >> 5) & 1, h = (unit >> 6) & 3, n = unit >> 8;
        float beta[16], lf[16]; unsigned short vv[16];
        const bf16_t* lfb = LF + ((size_t)dir * M + (size_t)n * 2048) * HGW + h * 128; const bf16_t* vhb = Vh + (size_t)n * 2048 * HGW + h * 128;
        unsigned bo0 = (unsigned)d * 2u; asm volatile("" : "+v"(bo0));
#pragma unroll
        for (int j = 0; j < 16; ++j) { const int f = 64 * c + 16 * I + j; const int tok = dir ? (2047 - f) : f; const unsigned bo = (unsigned)(tok * (HGW * 2)) + bo0;
            lf[j] = bf2f(*(const bf16_t*)((const char*)lfb + bo)); vv[j] = *(const bf16_t*)((const char*)vhb + bo); }
        float run = 0.f;
#pragma unroll
        for (int j = 0; j < 16; ++j) { run += lf[j]; beta[j] = run; }
        Ts[I * 128 + d] = run;
        __syncthreads();
        const float T0 = Ts[d], T1 = Ts[128 + d], T2 = Ts[256 + d], T3 = Ts[384 + d];
        const float r4 = (T0 + T1) + (T2 + T3);
        const float rI = (I > 0 ? T0 : 0.f) + (I > 1 ? T1 : 0.f) + (I > 2 ? T2 : 0.f);
        const float base = r4 - rI;
        unsigned kw[8], vw[8];
#pragma unroll
        for (int j = 0; j < 8; ++j) {
            const float k0 = (1.f - fexp(lf[2 * j])) * fexp(base - beta[2 * j]), k1 = (1.f - fexp(lf[2 * j + 1])) * fexp(base - beta[2 * j + 1]);
            kw[j] = pk2(k0, k1); vw[j] = (unsigned)vv[2 * j] | ((unsigned)vv[2 * j + 1] << 16); }
        { u32x4 a; a.x = kw[0]; a.y = kw[1]; a.z = kw[2]; a.w = kw[3]; u32x4 bq; bq.x = kw[4]; bq.y = kw[5]; bq.z = kw[6]; bq.w = kw[7];
          *(LAS u32x4*)(kdT + d * 144 + I * 32) = a; *(LAS u32x4*)(kdT + d * 144 + I * 32 + 16) = bq; }
        { u32x4 a; a.x = vw[0]; a.y = vw[1]; a.z = vw[2]; a.w = vw[3]; u32x4 bq; bq.x = vw[4]; bq.y = vw[5]; bq.z = vw[6]; bq.w = vw[7];
          *(LAS u32x4*)(vT + d * 144 + I * 32) = a; *(LAS u32x4*)(vT + d * 144 + I * 32 + 16) = bq; }
        if (I == 0) G[(size_t)unit * 128 + d] = fexp(r4);
        __syncthreads();
        bf16x8 bfr[2];
#pragma unroll
        for (int ks = 0; ks < 2; ++ks) bfr[ks] = *(const LAS bf16x8*)(vT + (16 * wid + fr) * 144 + (32 * ks + 8 * fq) * 2);
        bf16_t* up = UT + ((size_t)unit * 128 + 16 * wid + fr) * 128 + 4 * fq;
#pragma unroll
        for (int mb = 0; mb < 8; ++mb) {
            f32x4 acc = {0.f, 0.f, 0.f, 0.f};
#pragma unroll
            for (int ks = 0; ks < 2; ++ks) { const bf16x8 a = *(const LAS bf16x8*)(kdT + (16 * mb + fr) * 144 + (32 * ks + 8 * fq) * 2);
                acc = __builtin_amdgcn_mfma_f32_16x16x32_bf16(a, bfr[ks], acc, 0, 0, 0); }
            u32x2 w; w.x = pk2(acc[0], acc[1]); w.y = pk2(acc[2], acc[3]);
            *(u32x2*)(up + 16 * mb) = w;
        }
        __syncthreads();
    }
}

__device__ __forceinline__ void h2_phase(bf16_t* UT, const float* G) {
    const int gt = blockIdx.x * 512 + otid(), GN = gridDim.x * 512;
    for (int item = gt + GN; item < 64 * 2048; item += GN) {
        const int seq = item >> 11, rem = item & 2047, e = rem >> 4, d0 = (rem & 15) * 8;
        float S[8];
#pragma unroll
        for (int i = 0; i < 8; ++i) S[i] = 0.f;
#pragma unroll 4
        for (int c = 0; c < 32; ++c) {
            const size_t unit = (size_t)seq * 32 + c;
            bf16_t* p = UT + (unit * 128 + e) * 128 + d0;
            const u32x4 uw = *(const u32x4*)p;
            const f32x4 g0 = *(const f32x4*)(G + unit * 128 + d0), g1 = *(const f32x4*)(G + unit * 128 + d0 + 4);
            u32x4 o; o.x = pk2(S[0], S[1]); o.y = pk2(S[2], S[3]); o.z = pk2(S[4], S[5]); o.w = pk2(S[6], S[7]);
            *(u32x4*)p = o;
            S[0] = g0[0] * S[0] + bflo(uw.x); S[1] = g0[1] * S[1] + bfhi(uw.x); S[2] = g0[2] * S[2] + bflo(uw.y); S[3] = g0[3] * S[3] + bfhi(uw.y);
            S[4] = g1[0] * S[4] + bflo(uw.z); S[5] = g1[1] * S[5] + bfhi(uw.z); S[6] = g1[2] * S[6] + bflo(uw.w); S[7] = g1[3] * S[7] + bfhi(uw.w);
        }
    }
}

constexpr int H3_TS = 0, H3_RED = 2048, H3_RSV = 4096, H3_QT = 4352, H3_QB = 21760, H3_KV = 39168, H3_VT = 82688, H3_P = 101120, H3_END = 110336;
__device__ __forceinline__ void h3_load(int unit, int dir, unsigned bo0, int I, const bf16_t* LF, const bf16_t* Qh, const bf16_t* Vh, unsigned (&lq)[16], unsigned (&vw)[8]) {
    const int c = unit & 31, h = (unit >> 5) & 3, n = unit >> 7;
    const size_t ub = ((size_t)n * 2048 + 64 * c) * HGW + h * 128;
    const bf16_t* lfb = LF + (size_t)dir * M * HGW + ub; const bf16_t* qhb = Qh + ub; const bf16_t* vhb = Vh + ub;
#pragma unroll
    for (int j = 0; j < 16; ++j) { const int t = 16 * I + j; const int p = dir ? (63 - t) : t; const unsigned bo = (unsigned)(p * (HGW * 2)) + bo0;
        lq[j] = (unsigned)*(const bf16_t*)((const char*)lfb + bo) | ((unsigned)*(const bf16_t*)((const char*)qhb + bo) << 16);
        const unsigned v = (unsigned)*(const bf16_t*)((const char*)vhb + bo);
        if (j & 1) vw[j >> 1] |= v << 16; else vw[j >> 1] = v; }
}
__device__ __forceinline__ void h3_phase(LAS unsigned char* lds, const bf16_t* LF, const bf16_t* Qh, const bf16_t* Vh, const bf16_t* Gh, const bf16_t* ST, const float* hgain, bf16_t* ymix) {
    const int tid = otid(), wid = tid >> 6, lane = tid & 63, fr = lane & 15, fq = lane >> 4;
    const int d = tid & 127, I = tid >> 7;
    LAS float* Ts = (LAS float*)(lds + H3_TS); LAS float* red = (LAS float*)(lds + H3_RED); LAS float* rsv = (LAS float*)(lds + H3_RSV);
    LAS unsigned char* qt = lds + H3_QT; LAS unsigned char* qbL = lds + H3_QB; LAS unsigned char* kv = lds + H3_KV; LAS unsigned char* vT = lds + H3_VT; LAS unsigned char* P = lds + H3_P;
    for (int i = tid; i < 9216 / 4; i += 512) ((LAS unsigned*)P)[i] = 0u;
    __syncthreads();
    int ndu = 0;
    for (int u = blockIdx.x; u < 1024; u += gridDim.x) ndu += 2;
    unsigned lqn[16], vwn[8];
#pragma unroll
    for (int j = 0; j < 16; ++j) lqn[j] = 0u;
#pragma unroll
    for (int j = 0; j < 8; ++j) vwn[j] = 0u;
    if (ndu > 0) { unsigned bo0 = (unsigned)d * 2u; asm volatile("" : "+v"(bo0)); h3_load(blockIdx.x, 0, bo0, I, LF, Qh, Vh, lqn, vwn); }
    f32x4 acc[4];
#pragma unroll
    for (int mb = 0; mb < 4; ++mb) acc[mb] = (f32x4){0.f, 0.f, 0.f, 0.f};
#pragma unroll 1
    for (int du = 0; du < ndu; ++du) {
        const int unit = blockIdx.x + (du >> 1) * gridDim.x, dir = du & 1;
        const int c = unit & 31, h = (unit >> 5) & 3, n = unit >> 7;
        unsigned lq[16], vw[8];
#pragma unroll
        for (int j = 0; j < 16; ++j) lq[j] = lqn[j];
#pragma unroll
        for (int j = 0; j < 8; ++j) vw[j] = vwn[j];
#if 0
        if (du + 1 < ndu) { unsigned bo0 = (unsigned)d * 2u; asm volatile("" : "+v"(bo0)); h3_load(blockIdx.x + ((du + 1) >> 1) * gridDim.x, (du + 1) & 1, bo0, I, LF, Qh, Vh, lqn, vwn); }
#else
        { unsigned bo0 = (unsigned)d * 2u; asm volatile("" : "+v"(bo0)); h3_load(unit, dir, bo0, I, LF, Qh, Vh, lq, vw); }
#endif
        const int cs = dir ? (31 - c) : c; const size_t su = ((size_t)((n * 4 + h) * 2 + dir)) * 32 + cs;
        bf16x8 sfr[4];
#pragma unroll
        for (int ks = 0; ks < 4; ++ks) sfr[ks] = *(const bf16x8*)(ST + (su * 128 + 16 * wid + fr) * 128 + 32 * ks + 8 * fq);
        unsigned ghw[8];
#pragma unroll
        for (int j = 0; j < 8; ++j) ghw[j] = 0u;
        if (dir == 1) { unsigned eo = (unsigned)(16 * wid + fr) * 2u; asm volatile("" : "+v"(eo));
            const bf16_t* ghb = Gh + ((size_t)n * 2048 + 64 * c) * HGW + h * 128;
#pragma unroll
            for (int mb = 0; mb < 4; ++mb)
#pragma unroll
                for (int j = 0; j < 4; ++j) { const int p = 16 * mb + 4 * fq + j; const unsigned v = (unsigned)*(const bf16_t*)((const char*)ghb + ((unsigned)(p * (HGW * 2)) + eo));
                    if (j & 1) ghw[2 * mb + (j >> 1)] |= v << 16; else ghw[2 * mb + (j >> 1)] = v; } }
        float beta[16];
        float run = 0.f;
#pragma unroll
        for (int j = 0; j < 16; ++j) { run += bflo(lq[j]); beta[j] = run; }
        Ts[I * 128 + d] = run;
        __syncthreads();
        const float T0 = Ts[d], T1 = Ts[128 + d], T2 = Ts[256 + d];
        const float rI = (I > 0 ? T0 : 0.f) + (I > 1 ? T1 : 0.f) + (I > 2 ? T2 : 0.f);
        const float TI = (I == 0) ? T0 : (I == 1) ? T1 : (I == 2) ? T2 : 0.f;
        const float TI1 = (I == 0) ? T1 : (I == 1) ? T2 : 0.f;
        const float TI2 = (I == 0) ? T2 : 0.f;
        const float e_rI = fexp(rI);
        const float E1 = fexp(TI), E2 = fexp(TI + TI1), E3 = fexp(TI + TI1 + TI2);
        const int vb0 = (I == 0) ? 0 : (I == 1) ? 16 : (I == 2) ? 48 : 96;
        const int vb1 = (I == 0) ? 16 : (I == 1) ? 48 : 96, vb2 = (I == 0) ? 48 : 96;
#pragma unroll
        for (int j = 0; j < 16; ++j) {
            const int t = 16 * I + j;
            const float eb = fexp(beta[j]); const float qe = bfhi(lq[j]) * eb;
            *(LAS unsigned short*)(qt + t * 272 + d * 2) = f2bf(qe);
            *(LAS unsigned short*)(qbL + t * 272 + d * 2) = f2bf(qe * e_rI);
            const float k = 1.f - fexp(bflo(lq[j]));
            const float kd = k * fexp(-beta[j]);
            *(LAS unsigned short*)(kv + (vb0 + t) * 272 + d * 2) = f2bf(kd);
            if (I < 3) *(LAS unsigned short*)(kv + (vb1 + t) * 272 + d * 2) = f2bf(kd * E1);
            if (I < 2) *(LAS unsigned short*)(kv + (vb2 + t) * 272 + d * 2) = f2bf(kd * E2);
            if (I < 1) *(LAS unsigned short*)(kv + (96 + t) * 272 + d * 2) = f2bf(kd * E3);
            if ((j & 3) == 3) __builtin_amdgcn_sched_barrier(0);
        }
        { u32x4 a; a.x = vw[0]; a.y = vw[1]; a.z = vw[2]; a.w = vw[3]; u32x4 bq; bq.x = vw[4]; bq.y = vw[5]; bq.z = vw[6]; bq.w = vw[7];
          *(LAS u32x4*)(vT + d * 144 + I * 32) = a; *(LAS u32x4*)(vT + d * 144 + I * 32 + 16) = bq; }
        __syncthreads();
        for (int blk = wid; blk < 10; blk += 8) {
            const int Ib = (blk < 1) ? 0 : (blk < 3) ? 1 : (blk < 6) ? 2 : 3;
            const int Jb = blk - ((Ib * (Ib + 1)) >> 1);
            const int vbI = (Ib == 0) ? 0 : (Ib == 1) ? 16 : (Ib == 2) ? 48 : 96;
            f32x4 sc = {0.f, 0.f, 0.f, 0.f};
#pragma unroll
            for (int ks = 0; ks < 4; ++ks) {
                const bf16x8 a = *(const LAS bf16x8*)(qt + (16 * Ib + fr) * 272 + (32 * ks + 8 * fq) * 2);
                const bf16x8 bb = *(const LAS bf16x8*)(kv + (vbI + 16 * Jb + fr) * 272 + (32 * ks + 8 * fq) * 2);
                sc = __builtin_amdgcn_mfma_f32_16x16x32_bf16(a, bb, sc, 0, 0, 0);
            }
#pragma unroll
            for (int j = 0; j < 4; ++j) { float v = sc[j]; if (Ib == Jb && fr > 4 * fq + j) v = 0.f;
                *(LAS unsigned short*)(P + (16 * Ib + 4 * fq + j) * 144 + (16 * Jb + fr) * 2) = f2bf(v); }
        }
        __syncthreads();
#pragma unroll
        for (int mb = 0; mb < 4; ++mb) {
            const int p = 16 * mb + fr; const int tr = dir ? (63 - p) : p;
#pragma unroll
            for (int ks = 0; ks < 4; ++ks) { const bf16x8 a = *(const LAS bf16x8*)(qbL + tr * 272 + (32 * ks + 8 * fq) * 2);
                acc[mb] = __builtin_amdgcn_mfma_f32_16x16x32_bf16(a, sfr[ks], acc[mb], 0, 0, 0); }
#pragma unroll
            for (int ks = 0; ks < 2; ++ks) { const bf16x8 a = *(const LAS bf16x8*)(P + tr * 144 + (32 * ks + 8 * fq) * 2);
                const bf16x8 bv = *(const LAS bf16x8*)(vT + (16 * wid + fr) * 144 + (32 * ks + 8 * fq) * 2);
                acc[mb] = __builtin_amdgcn_mfma_f32_16x16x32_bf16(a, bv, acc[mb], 0, 0, 0); }
            __builtin_amdgcn_sched_barrier(0);
        }
        __syncthreads();
        if (dir == 0) continue;
#pragma unroll
        for (int mb = 0; mb < 4; ++mb)
#pragma unroll
            for (int j = 0; j < 4; ++j) { float s = acc[mb][j] * acc[mb][j];
                s += __shfl_xor(s, 1); s += __shfl_xor(s, 2); s += __shfl_xor(s, 4); s += __shfl_xor(s, 8);
                if (fr == 0) red[wid * 64 + 16 * mb + 4 * fq + j] = s; }
        __syncthreads();
        if (tid < 64) { float t = 0.f;
#pragma unroll
            for (int w = 0; w < 8; ++w) t += red[w * 64 + tid];
            rsv[tid] = rsqrtf(t * (1.f / 128.f) + EPS); }
        __syncthreads();
        const int e = 16 * wid + fr; const float ge = hgain[e];
        unsigned eo = (unsigned)e * 2u; asm volatile("" : "+v"(eo));
        bf16_t* ymb = ymix + ((size_t)n * 2048 + 64 * c) * D + h * 128;
#pragma unroll
        for (int mb = 0; mb < 4; ++mb) {
#pragma unroll
            for (int j = 0; j < 4; ++j) { const int p = 16 * mb + 4 * fq + j;
                const unsigned gw2 = ghw[2 * mb + (j >> 1)]; const float y = acc[mb][j] * rsv[p] * ge * ((j & 1) ? bfhi(gw2) : bflo(gw2));
                *(bf16_t*)((char*)ymb + ((unsigned)(p * (D * 2)) + eo)) = f2bf(y); }
            acc[mb] = (f32x4){0.f, 0.f, 0.f, 0.f};
        }
    }
}

#ifdef DIAG
__device__ __forceinline__ void nan_check_bf16(const bf16_t* buf, size_t n, unsigned* flag) {
    const size_t gt = (size_t)blockIdx.x * 512 + otid(), GN = (size_t)gridDim.x * 512; unsigned bad = 0;
#pragma unroll 1
    for (size_t i = gt; i < n / 2; i += GN) { const unsigned w = ((const unsigned*)buf)[i]; if ((w & 0x7f80u) == 0x7f80u || (w & 0x7f800000u) == 0x7f800000u) bad = 1; }
    if (bad) atomicOr(flag, 1u);
}
__device__ __forceinline__ void nan_check_f32(const float* buf, size_t n, unsigned* flag) {
    const size_t gt = (size_t)blockIdx.x * 512 + otid(), GN = (size_t)gridDim.x * 512; unsigned bad = 0;
#pragma unroll 1
    for (size_t i = gt; i < n; i += GN) { const unsigned w = __float_as_uint(buf[i]); if ((w & 0x7f800000u) == 0x7f800000u) bad = 1; }
    if (bad) atomicOr(flag, 1u);
}
#define DCHK_BF(buf, n, slot) nan_check_bf16(buf, n, DIAGW + (slot))
#define DCHK_F(buf, n, slot) nan_check_f32(buf, n, DIAGW + (slot))
#else
#define DCHK_BF(buf, n, slot)
#define DCHK_F(buf, n, slot)
#endif

#ifndef STOP_AT
#define STOP_AT 0
#endif
__device__ __forceinline__ void dump_bf16(const bf16_t* buf, float* out) {
    const size_t gt = (size_t)blockIdx.x * 512 + otid(), GN = (size_t)gridDim.x * 512;
#pragma unroll 1
    for (size_t i = gt; i < (size_t)M * D; i += GN) {
#ifdef DUMP_NANFLAG
        const unsigned short w = buf[i]; out[i] = ((w & 0x7f80u) == 0x7f80u) ? 1000.f : 0.f;
#else
        out[i] = bf2f(buf[i]);
#endif
    }
}
#ifndef STOP_L
#define STOP_L 0
#endif
#define STOPK(k, buf) if (a.stop_at == (k) && l == a.stop_l) { dump_bf16(buf, a.out); return; }
#define XB_TMO      128
#define XB_XCNT(j)  (256  + 64 * (j))
#define XB_XSUB(j)  (1280 + 64 * (j))
#define XB_XGEN(j)  (2304 + 64 * (j))
#define XB_TOP      3328
#define XB_TOPGEN   3392
#define XCD_BAR_WORDS 3456
#define XB_SPIN_CAP (1u << 18)

__device__ __forceinline__ unsigned xb_ld(unsigned* p)              { return __hip_atomic_load(p, __ATOMIC_RELAXED, __HIP_MEMORY_SCOPE_AGENT); }
__device__ __forceinline__ unsigned xb_add(unsigned* p, unsigned v) { return __hip_atomic_fetch_add(p, v, __ATOMIC_RELAXED, __HIP_MEMORY_SCOPE_AGENT); }
__device__ __forceinline__ unsigned xb_xcc_id() { return (unsigned)__builtin_amdgcn_s_getreg((3 << 11) | 20) & 0xFu; }
#define XB_SPIN(cond, bar) do { unsigned _sp = 0; while (cond) { __builtin_amdgcn_s_sleep(1); \
    if ((++_sp & 255u) == 0u) { if (xb_ld(&(bar)[XB_TMO])) break; if (_sp > XB_SPIN_CAP) { atomicAdd(&(bar)[XB_TMO], 1u); break; } } } } while (0)

struct XcdBarrier {
    unsigned* bar; unsigned x;
    volatile LAS unsigned* st;
};

__device__ __forceinline__ XcdBarrier xcd_barrier_post(unsigned* bar, volatile LAS unsigned* st) {
    XcdBarrier b; b.bar = bar; b.x = xb_xcc_id(); b.st = st;
    if (threadIdx.x == 0) (void)xb_add(&bar[XB_XCNT(b.x)], 1u);
    return b;
}
__device__ __forceinline__ void xcd_barrier_complete(unsigned* bar, unsigned x, unsigned& nloc, unsigned& nx) {
    const unsigned G = gridDim.x * gridDim.y * gridDim.z;
    unsigned sum, cnt, mine, sp = 0u;
    for (;;) {
        sum = 0u; cnt = 0u; mine = 0u;
#pragma unroll
        for (unsigned j = 0; j < 16; ++j) { const unsigned c = xb_ld(&bar[XB_XCNT(j)]); sum += c; cnt += (c > 0u) ? 1u : 0u; mine = (j == x) ? c : mine; }
        if (sum == G) break;
        __builtin_amdgcn_s_sleep(1);
        if ((++sp & 255u) == 0u) { if (xb_ld(&bar[XB_TMO])) break; if (sp > XB_SPIN_CAP) { atomicAdd(&bar[XB_TMO], 1u); break; } }
    }
    nloc = mine > 0u ? mine : 1u; nx = cnt > 0u ? cnt : 1u;
}

__device__ __forceinline__ void xcd_barrier(const XcdBarrier& b) {
    asm volatile("s_waitcnt vmcnt(0)" ::: "memory");
    __syncthreads();
    if (threadIdx.x == 0) {
        unsigned* bar = b.bar;
        __builtin_amdgcn_s_waitcnt(0);
        unsigned nloc = b.st[0], nx = b.st[1];
        if (nloc == 0u) { xcd_barrier_complete(bar, b.x, nloc, nx); b.st[0] = nloc; b.st[1] = nx; }
        const unsigned old = xb_add(&bar[XB_XSUB(b.x)], 1u);
        const unsigned gen = old / nloc;
        if (old + 1u == (gen + 1u) * nloc) {
            __builtin_amdgcn_fence(__ATOMIC_RELEASE, "agent");
            asm volatile("s_waitcnt vmcnt(0)" ::: "memory");
            const unsigned og = xb_add(&bar[XB_TOP], 1u);
            const unsigned tg = og / nx;
            if (og + 1u == (tg + 1u) * nx) xb_add(&bar[XB_TOPGEN], 1u);
            else XB_SPIN(xb_ld(&bar[XB_TOPGEN]) == tg, bar);
            __builtin_amdgcn_fence(__ATOMIC_ACQUIRE, "agent");
            xb_add(&bar[XB_XGEN(b.x)], 1u);
            asm volatile("s_waitcnt vmcnt(0)" ::: "memory");
        } else {
            XB_SPIN(xb_ld(&bar[XB_XGEN(b.x)]) == gen, bar);
            __builtin_amdgcn_fence(__ATOMIC_ACQUIRE, "agent");
            asm volatile("s_waitcnt vmcnt(0)" ::: "memory");
        }
    }
    __syncthreads();
}

__global__ void __launch_bounds__(512, 2) hybrid_fwd(Args a) {
    extern __shared__ __attribute__((aligned(16))) unsigned char lds_raw[];
    LAS unsigned char* lds = (LAS unsigned char*)lds_raw;
    cg::grid_group grid = cg::this_grid();
    { volatile LAS unsigned* st0 = (volatile LAS unsigned*)(lds + 140000); if (threadIdx.x < 2) st0[threadIdx.x] = 0u; __syncthreads(); }
    const XcdBarrier xbar = xcd_barrier_post((unsigned*)(a.ws + WS_CTL + 524288), (volatile LAS unsigned*)(lds + 140000));
#define GSYNC() xcd_barrier(xbar)
    unsigned char* ws = a.ws;
    float* COND = (float*)(ws + WS_CTL + CT_COND); float* ROWSS = (float*)(ws + WS_RSP); float* LBT = (float*)(ws + WS_CTL + CT_LBT);
    bf16_t* WINT = (bf16_t*)(ws + WS_WIN); bf16_t* WOUTT = (bf16_t*)(ws + WS_WOUT); bf16_t* W1T = (bf16_t*)(ws + WS_W1); bf16_t* W2T = (bf16_t*)(ws + WS_W2);
    bf16_t* ABUF = (bf16_t*)(ws + WS_ABUF);
    bf16_t* QH = (bf16_t*)(ws + WS_QH); bf16_t* LF = (bf16_t*)(ws + WS_LF); bf16_t* VH = (bf16_t*)(ws + WS_VH); bf16_t* GH = (bf16_t*)(ws + WS_GH);
    bf16_t* AQ = (bf16_t*)(ws + WS_AQ); bf16_t* AK = (bf16_t*)(ws + WS_AK); bf16_t* VT = (bf16_t*)(ws + WS_VT);
    bf16_t* ST = (bf16_t*)(ws + WS_ST); float* GG = (float*)(ws + WS_G);
    unsigned* DIAGW = (unsigned*)(ws + WS_CTL + 500000); (void)DIAGW;
    bf16_t* YRAW1 = (bf16_t*)(ws + WS_YRAW1); bf16_t* UB = (bf16_t*)(ws + WS_U); bf16_t* YRAW2 = (bf16_t*)(ws + WS_YRAW2);

    {
        const int tid = otid(), lane = tid & 63, wave = tid >> 6;
        LAS float* sc = (LAS float*)lds;
        LAS float* part = (LAS float*)(lds + 32768);
        if ((int)blockIdx.x < 192) {
            for (int i = tid; i < 8 * D; i += 512) sc[i] = siluf(a.c[i]);
            __syncthreads();
        }
        for (int ib = blockIdx.x; ib < 192; ib += gridDim.x) {
            const int col = tid & 31, kg = tid >> 5, j = ib * 32 + col;
            float ac[8];
#pragma unroll
            for (int b = 0; b < 8; ++b) ac[b] = 0.f;
#pragma unroll 8
            for (int kk = 0; kk < 64; ++kk) { const int k = kg * 64 + kk; const float w = a.w_ada[(size_t)k * NMOD6 + j];
#pragma unroll
                for (int b = 0; b < 8; ++b) ac[b] += sc[b * D + k] * w; }
#pragma unroll
            for (int b = 0; b < 8; ++b) part[(kg * 8 + b) * 32 + col] = ac[b];
            __syncthreads();
            if (tid < 256) { const int b = tid >> 5; float t = 0.f;
#pragma unroll
                for (int g = 0; g < 16; ++g) t += part[(g * 8 + b) * 32 + col];
                COND[b * NMOD6 + ib * 32 + col] = t; }
            __syncthreads();
        }
        if (blockIdx.x == gridDim.x - 1) { const float l0 = a.lb_logits[tid], l1 = a.lb_logits[HGW + tid]; LBT[tid] = 0.f; LBT[HGW + tid] = 1.f / (1.f + __expf(l0 - l1)); }
        LAS float* scr = (LAS float*)(lds + 49152 + wave * 8448);
        const int gw = blockIdx.x * 8 + wave, NGW = gridDim.x * 8;
        constexpr int I_IN = (D / 64) * (INC / 32), I_OUT = (D / 64) * (D / 32), I_1 = (D / 64) * (FF / 32), I_2 = (FF / 64) * (D / 32), I_L = I_IN + I_OUT + I_1 + I_2;
        for (int it = gw; it < 2 * I_L; it += NGW) {
            const int l = it / I_L; int r = it % I_L;
            if (r < I_IN) { transpose_item(a.w_in + (size_t)l * D * INC, D, INC, WINT + (size_t)l * INC * D, scr, r, lane); continue; } r -= I_IN;
            if (r < I_OUT) { transpose_item(a.w_out + (size_t)l * D * D, D, D, WOUTT + (size_t)l * D * D, scr, r, lane); continue; } r -= I_OUT;
            if (r < I_1) { transpose_item(a.w_ff1 + (size_t)l * D * FF, D, FF, W1T + (size_t)l * FF * D, scr, r, lane); continue; } r -= I_1;
            transpose_item(a.w_ff2 + (size_t)l * FF * D, FF, D, W2T + (size_t)l * D * FF, scr, r, lane);
        }
    }
    grid.sync();

    row_phase(a.x, nullptr, nullptr, nullptr, nullptr, COND, nullptr, 0, ABUF, a.pre_mix, a.ada_bias, 0, 1);
    GSYNC();
    { const int l = 0; STOPK(1, ABUF) }
    DCHK_BF(ABUF, (size_t)M * D, 0); DCHK_BF(WINT, (size_t)2 * INC * D, 1); DCHK_BF(W1T, (size_t)2 * FF * D, 1); DCHK_BF(W2T, (size_t)2 * FF * D, 1); DCHK_BF(WOUTT, (size_t)2 * D * D, 1);
#pragma unroll 1
    for (int l = 0; l < 2; ++l) {
        const float* biasl = a.ada_bias + (size_t)l * NMOD6;
        STOPK(11, ABUF)
        { pg8::Gemm g{ABUF, WINT + (size_t)l * INC * D, M, INC, D}; pg8::StaticOrder S; S.init(M, INC, (int)gridDim.x, (int)blockIdx.x);
          EpiIn E{QH, LF, VH, GH, AQ, AK, VT, LBT + l * HGW};
#ifndef SKIP_G1
#ifdef REP_GEMM
          pg8::gemm_phase<EpiIn, pg8::StaticOrder, true, true>(lds, g, S, E);
#endif
          pg8::gemm_phase<EpiIn, pg8::StaticOrder, true, true>(lds, g, S, E);
#endif
        }
        GSYNC();
        STOPK(2, LF) STOPK(12, QH) STOPK(13, AQ)
        DCHK_BF(QH, (size_t)M * HGW, 2 + 16 * l); DCHK_BF(LF, (size_t)2 * M * HGW, 3 + 16 * l); DCHK_BF(VH, (size_t)M * HGW, 4 + 16 * l); DCHK_BF(GH, (size_t)M * HGW, 4 + 16 * l); DCHK_BF(AQ, (size_t)M * HGW, 5 + 16 * l); DCHK_BF(AK, (size_t)M * 128, 5 + 16 * l); DCHK_BF(VT, (size_t)M * 128, 5 + 16 * l);
#ifdef REP_MIX
        attn_prep(AQ, AK, a.q_gain + l * 64, a.k_gain + l * 64);
#pragma unroll 1
        for (int rep = 0; rep < 2; ++rep) {
#define SKIP_PREP
#endif
#ifndef SKIP_H1
        h1_phase(lds, LF, VH, ST, GG);
#endif
#ifdef REP_H1
        h1_phase(lds, LF, VH, ST, GG);
#endif
#ifndef SKIP_PREP
        attn_prep(AQ, AK, a.q_gain + l * 64, a.k_gain + l * 64);
#endif
        GSYNC();
        STOPK(3, ST) STOPK(14, AQ)
        DCHK_BF(ST, (size_t)2048 * 128 * 128, 6 + 16 * l); DCHK_F(GG, (size_t)2048 * 128, 6 + 16 * l); DCHK_BF(AQ, (size_t)M * HGW, 7 + 16 * l); DCHK_BF(AK, (size_t)M * 128, 7 + 16 * l);
#ifndef SKIP_H2
        h2_phase(ST, GG);
#endif
#ifndef SKIP_ATT
        attn_phase(lds, AQ, AK, VT, ABUF, a.ao_gain + l * 64, ST, GG, a.q_gain + l * 64, a.k_gain + l * 64);
#endif
#ifdef REP_ATT
        attn_phase(lds, AQ, AK, VT, ABUF, a.ao_gain + l * 64, ST, GG, a.q_gain + l * 64, a.k_gain + l * 64);
#endif
        GSYNC();
        STOPK(4, ST) STOPK(15, ABUF)
        DCHK_BF(ST, (size_t)2048 * 128 * 128, 8 + 16 * l); DCHK_BF(ABUF, (size_t)M * D, 9 + 16 * l);
#ifndef SKIP_H3
        h3_phase(lds, LF, QH, VH, GH, ST, a.hg_gain + l * 128, ABUF);
#endif
#ifdef REP_H3
        h3_phase(lds, LF, QH, VH, GH, ST, a.hg_gain + l * 128, ABUF);
#endif
        GSYNC();
        STOPK(5, ABUF)
        DCHK_BF(ABUF, (size_t)M * D, 10 + 16 * l);
#ifdef REP_MIX
        }
#endif
        { pg8::Gemm g{ABUF, WOUTT + (size_t)l * D * D, M, D, D}; pg8::StaticOrder S; S.init(M, D, (int)gridDim.x, (int)blockIdx.x);
          EpiRaw E{YRAW1, ROWSS};
#ifndef SKIP_G2
#ifdef REP_GEMM
          pg8::gemm_phase<EpiRaw, pg8::StaticOrder, true, true>(lds, g, S, E);
#endif
          pg8::gemm_phase<EpiRaw, pg8::StaticOrder, true, true>(lds, g, S, E);
#endif
        }
        GSYNC();
        STOPK(6, YRAW1)
        DCHK_BF(YRAW1, (size_t)M * D, 11 + 16 * l);
        row_phase(l == 0 ? a.x : a.out, a.out, YRAW1, ROWSS, a.post_mix + l * D, COND, biasl, 2, ABUF, a.pre_ff + l * D, biasl, 3, 4);
        GSYNC();
        if (a.stop_at == 7 && l == a.stop_l) return;
        DCHK_F(a.out, (size_t)M * D, 12 + 16 * l); DCHK_BF(ABUF, (size_t)M * D, 12 + 16 * l);
        { pg8::Gemm g{ABUF, W1T + (size_t)l * FF * D, M, FF, D}; pg8::StaticOrder S; S.init(M, FF, (int)gridDim.x, (int)blockIdx.x);
          EpiRelu2 E{UB};
#ifndef SKIP_G3
#ifdef REP_GEMM
          pg8::gemm_phase<EpiRelu2, pg8::StaticOrder, true, true>(lds, g, S, E);
#endif
          pg8::gemm_phase<EpiRelu2, pg8::StaticOrder, true, true>(lds, g, S, E);
#endif
        }
        GSYNC();
        STOPK(8, UB)
        DCHK_BF(UB, (size_t)M * FF, 13 + 16 * l);
        { pg8::Gemm g{UB, W2T + (size_t)l * D * FF, M, D, FF}; pg8::StaticOrder S; S.init(M, D, (int)gridDim.x, (int)blockIdx.x);
          EpiRaw E{YRAW2, ROWSS};
#ifndef SKIP_G4
#ifdef REP_GEMM
          pg8::gemm_phase<EpiRaw, pg8::StaticOrder, true, true>(lds, g, S, E);
#endif
          pg8::gemm_phase<EpiRaw, pg8::StaticOrder, true, true>(lds, g, S, E);
#endif
        }
        GSYNC();
        STOPK(9, YRAW2)
        DCHK_BF(YRAW2, (size_t)M * D, 14 + 16 * l);
#ifdef HDEBUG
        row_phase<true>
#else
        row_phase<false>
#endif
            (a.out, a.out, YRAW2, ROWSS, a.post_ff + l * D, COND, biasl, 5, l == 0 ? ABUF : nullptr, a.pre_mix + D, a.ada_bias + NMOD6, 0, 1);
        if (a.stop_at == 10 && l == a.stop_l) return;
        if (l == 0) GSYNC();
    }
#ifdef DIAG
    GSYNC();
    DCHK_F(a.out, (size_t)M * D, 31);
    GSYNC();
    { int first = -1; for (int k = 0; k < 32; ++k) if (first < 0 && DIAGW[k]) first = k;
      if (first >= 0) { const size_t gt = (size_t)blockIdx.x * 512 + otid(), GN = (size_t)gridDim.x * 512;
          for (size_t i = gt; i < (size_t)M * D; i += GN) a.out[i] = (i == 0) ? 1000.f * (float)(first + 1) : 0.f; } }
#endif
}

extern "C" void kernel_launch(void* const* d_in, const int* in_sizes, int n_in, void* d_out, int out_size, void* d_ws, size_t ws_size, hipStream_t stream) {
    static int grid = 0;
    if (grid == 0) {
        if (n_in != 17 || in_sizes[0] != M * D || out_size != M * D || ws_size < WS_END) { fprintf(stderr, "kernel_launch: unexpected shapes (n_in %d, in0 %d, out %d, ws %zu)\n", n_in, n_in > 0 ? in_sizes[0] : -1, out_size, ws_size); grid = -1; return; }
        int dev = 0, cus = 0, per_cu = 0;
        if (hipGetDevice(&dev) != hipSuccess || hipDeviceGetAttribute(&cus, hipDeviceAttributeMultiprocessorCount, dev) != hipSuccess) { grid = -1; return; }
        if (hipFuncSetAttribute((const void*)hybrid_fwd, hipFuncAttributeMaxDynamicSharedMemorySize, LDS_BYTES) != hipSuccess) { fprintf(stderr, "hipFuncSetAttribute failed\n"); grid = -1; return; }
        if (hipOccupancyMaxActiveBlocksPerMultiprocessor(&per_cu, (const void*)hybrid_fwd, 512, LDS_BYTES) != hipSuccess || per_cu < 1) { fprintf(stderr, "occupancy query: %d\n", per_cu); (void)hipGetLastError(); per_cu = 1; }
        grid = cus * 1;
    }
    if (grid < 0) return;
    if (hipMemsetAsync((char*)d_ws + WS_CTL + 524288, 0, 16384, stream) != hipSuccess) { fprintf(stderr, "memset failed\n"); return; }
    Args a{};
    a.x = (const float*)d_in[0]; a.c = (const float*)d_in[1]; a.w_ada = (const float*)d_in[2]; a.ada_bias = (const float*)d_in[3]; a.lb_logits = (const float*)d_in[4];
    a.pre_mix = (const float*)d_in[5]; a.post_mix = (const float*)d_in[6]; a.w_in = (const float*)d_in[7]; a.w_out = (const float*)d_in[8]; a.hg_gain = (const float*)d_in[9];
    a.q_gain = (const float*)d_in[10]; a.k_gain = (const float*)d_in[11]; a.ao_gain = (const float*)d_in[12]; a.pre_ff = (const float*)d_in[13]; a.post_ff = (const float*)d_in[14];
    a.w_ff1 = (const float*)d_in[15]; a.w_ff2 = (const float*)d_in[16];
    a.out = (float*)d_out; a.ws = (unsigned char*)d_ws; a.stop_at = STOP_AT; a.stop_l = STOP_L;
    void* args[] = {&a};
    hipError_t e = hipLaunchCooperativeKernel((const void*)hybrid_fwd, dim3(grid), dim3(512), args, LDS_BYTES, stream);
    if (e != hipSuccess) fprintf(stderr, "cooperative launch failed: %s (grid %d)\n", hipGetErrorString(e), grid);
}
```

```cpp
#include <hip/hip_runtime.h>
#include <hip/hip_cooperative_groups.h>
#include <cstdio>
#include <cstdint>
namespace cg = cooperative_groups;
namespace pg8 {
#define PG8_LAS __attribute__((address_space(3)))
typedef unsigned short bf16_t;
typedef short bf16x8 __attribute__((ext_vector_type(8)));
typedef float f32x4 __attribute__((ext_vector_type(4)));
typedef unsigned u32x4 __attribute__((ext_vector_type(4)));
constexpr int BM = 256, BK = 64, HALF = 128, HTB = HALF * BK * 2  , STAGE_BYTES = 8 * HTB, NXCD = 8, WGM = 8;

__host__ __device__ __forceinline__ int lds_byte(int r, int c) { const int st = (r >> 4) * 2 + (c >> 5), rr = r & 15, cc = c & 31, ob = rr * 64 + cc * 2; return st * 1024 + (ob ^ (((ob >> 9) & 1) << 5)); }
__host__ __device__ __forceinline__ void stage_rc(int b, int& R, int& C) { const int st = b / 1024, sb = b % 1024, swz = sb ^ (((sb >> 9) & 1) << 5); R = (st >> 1) * 16 + swz / 64; C = (st & 1) * 32 + (swz % 64) / 2; }
__host__ __device__ __forceinline__ int perm32(int rho) { const int n = rho >> 4, i = rho & 15; return 8 * (i >> 2) + 4 * n + (i & 3); }

struct Unit { int pm, pn; };
struct Gemm { const bf16_t* A; const bf16_t* Bt; int M, N, K; };

struct StaticOrder {
    int nM, nN, nwg, G, c;
    __host__ __device__ void init(int M, int N, int G_, int c_) { nM = M / BM; nN = N / BM; nwg = nM * nN; G = G_; c = c_; }
    __host__ __device__ bool next(int i, Unit& u) const {
        const long L = (long)i * G + c; if (L >= nwg) return false;
        int wgid = (int)L; { const int q = nwg / NXCD, r = nwg % NXCD, xcd = wgid % NXCD, off = wgid / NXCD; wgid = (xcd < r ? xcd * (q + 1) : r * (q + 1) + (xcd - r) * q) + off; }
        const int nig = WGM * nN, gid = wgid / nig, fm = gid * WGM, gsz = (nM - fm) < WGM ? (nM - fm) : WGM;
        u.pm = fm + ((wgid % nig) % gsz); u.pn = (wgid % nig) / gsz; return true;
    }
    __device__ __forceinline__ void a_ready(const Unit&) const {}
    __device__ __forceinline__ void done(const Unit&) const {}
};

typedef float f32x2_cv __attribute__((ext_vector_type(2)));
typedef __bf16 bf16x2_cv __attribute__((ext_vector_type(2)));
__device__ __forceinline__ unsigned cvt_pk_bf16(float lo, float hi) { const f32x2_cv v = {lo, hi}; const bf16x2_cv b = __builtin_convertvector(v, bf16x2_cv); return __builtin_bit_cast(unsigned, b); }
template <class Epi, class Sched, bool ALIGN_EPI = false, bool SP2 = false>
__device__ __forceinline__ void gemm_phase(PG8_LAS unsigned char* lds, const Gemm g, const Sched& S, const Epi& E) {
    int tid = threadIdx.x; asm volatile("" : "+v"(tid)); const int wid = __builtin_amdgcn_readfirstlane(tid >> 6), lane = tid & 63, wr = wid >> 2, wc = wid & 3, fr = lane & 15, fq = lane >> 4;
    const int K = g.K, nt = K / BK;
    unsigned voffA[2], voffB[2];
#pragma unroll
    for (int i = 0; i < 2; ++i) { int R, C; stage_rc(tid * 16 + i * 8192, R, C); const int Rb = Epi::PERM ? ((R & ~31) + perm32(R & 31)) : R;
        voffA[i] = (unsigned)(R * K + C) * 2u; voffB[i] = (unsigned)(Rb * K + C) * 2u; }
    const size_t kstep = (size_t)(BK * 2);
    const size_t hstep = (size_t)HALF * K * 2;
    const size_t tstep = 2 * hstep;
    const unsigned ldsw = (unsigned)wid * 1024u;
    const int aoff = lds_byte(wr * 64 + fr, fq * 8), boff = lds_byte(wc * 32 + fr, fq * 8);
#define PG8_SA(b, h) (((b) * 2 + (h)) * HTB)
#define PG8_SB(b, h) ((4 + (b) * 2 + (h)) * HTB)
#define PG8_STAGE(bufoff, gbase, voff) do { _Pragma("unroll") for (int _i = 0; _i < 2; ++_i) \
        __builtin_amdgcn_global_load_lds((const unsigned*)((const char*)(gbase) + (voff)[_i]), (PG8_LAS unsigned*)(lds + (bufoff) + ldsw + _i * 8192), 16, 0, 0); } while (0)
#define PG8_LDA(dst, b, h) do { _Pragma("unroll") for (int m = 0; m < 4; ++m) _Pragma("unroll") for (int k = 0; k < 2; ++k) dst[m][k] = *(const PG8_LAS bf16x8*)(lds + PG8_SA(b, h) + aoff + m * 2048 + k * 1024); } while (0)
#define PG8_LDB(dst, b, h) do { _Pragma("unroll") for (int n = 0; n < 2; ++n) _Pragma("unroll") for (int k = 0; k < 2; ++k) dst[n][k] = *(const PG8_LAS bf16x8*)(lds + PG8_SB(b, h) + boff + n * 2048 + k * 1024); } while (0)
#define PG8_MMA(ai, bj, At, Bt) do { __builtin_amdgcn_s_setprio(1); _Pragma("unroll") for (int m = 0; m < 4; ++m) _Pragma("unroll") for (int n = 0; n < 2; ++n) _Pragma("unroll") for (int k = 0; k < 2; ++k) \
        acc[ai][bj][m][n] = __builtin_amdgcn_mfma_f32_16x16x32_bf16(Bt[n][k], At[m][k], acc[ai][bj][m][n], 0, 0, 0); __builtin_amdgcn_s_setprio(0); } while (0)
#define PG8_WAIT_V(n) asm volatile("s_waitcnt vmcnt(" #n ")" ::: "memory")
#define PG8_WAIT_L(n) asm volatile("s_waitcnt lgkmcnt(" #n ")" ::: "memory")
#define PG8_BAR __builtin_amdgcn_s_barrier()
#define PG8_SCHED __builtin_amdgcn_sched_barrier(0)
    Unit cur, nxt; int ui = 0;
    if (!S.next(0, cur)) return;
    f32x4 acc[2][2][4][2];
#pragma unroll
    for (int a = 0; a < 2; ++a)
#pragma unroll
        for (int b = 0; b < 2; ++b)
#pragma unroll
            for (int m = 0; m < 4; ++m)
#pragma unroll
                for (int n = 0; n < 2; ++n) acc[a][b][m][n] = (f32x4){0.f, 0.f, 0.f, 0.f};
    bf16x8 At[4][2], B0[2][2], B1[2][2];
    const char* cA = (const char*)g.A + (size_t)cur.pm * tstep; const char* cB = (const char*)g.Bt + (size_t)cur.pn * tstep;
    S.a_ready(cur);
    if constexpr (SP2) {
        PG8_STAGE(PG8_SB(0, 0), cB, voffB); PG8_STAGE(PG8_SB(0, 1), cB + hstep, voffB); PG8_STAGE(PG8_SA(0, 0), cA, voffA); PG8_STAGE(PG8_SA(0, 1), cA + hstep, voffA);
        if (wr == 1) PG8_BAR;
        PG8_WAIT_V(2); PG8_BAR;
        PG8_STAGE(PG8_SB(1, 0), cB + kstep, voffB); PG8_STAGE(PG8_SA(1, 0), cA + kstep, voffA); PG8_STAGE(PG8_SB(1, 1), cB + hstep + kstep, voffB);
        PG8_WAIT_V(6); PG8_BAR;
    } else {
        PG8_STAGE(PG8_SB(0, 0), cB, voffB); PG8_STAGE(PG8_SA(0, 0), cA, voffA); PG8_STAGE(PG8_SB(0, 1), cB + hstep, voffB); PG8_STAGE(PG8_SA(0, 1), cA + hstep, voffA);
        if (wr == 1) PG8_BAR;
        PG8_WAIT_V(4); PG8_BAR;
        PG8_STAGE(PG8_SB(1, 0), cB + kstep, voffB); PG8_STAGE(PG8_SA(1, 0), cA + kstep, voffA); PG8_STAGE(PG8_SB(1, 1), cB + hstep + kstep, voffB);
        PG8_WAIT_V(6); PG8_BAR;
    }
    for (;;) {
        const bool has_next = S.next(ui + 1, nxt);
        const char* nA = has_next ? (const char*)g.A + (size_t)nxt.pm * tstep : cA; const char* nB = has_next ? (const char*)g.Bt + (size_t)nxt.pn * tstep : cB;
        for (int t = 0; t < nt; t += 2) {
            const bool last = (t == nt - 2);
            const char* a1 = cA + (size_t)(t + 1) * kstep;
            const char* a2 = last ? nA : cA + (size_t)(t + 2) * kstep; const char* b2 = last ? nB : cB + (size_t)(t + 2) * kstep;
            const char* a3 = a2 + kstep; const char* b3 = b2 + kstep;
            if (last && has_next) S.a_ready(nxt);
            if constexpr (SP2) {
            PG8_LDB(B0, 0, 0); PG8_LDB(B1, 0, 1); PG8_SCHED; PG8_LDA(At, 0, 0); PG8_STAGE(PG8_SA(1, 1), a1 + hstep, voffA);
            PG8_WAIT_V(8); PG8_WAIT_L(0); PG8_BAR; PG8_MMA(0, 0, At, B0); PG8_MMA(0, 1, At, B1); PG8_BAR; PG8_SCHED;
            PG8_LDA(At, 0, 1); PG8_STAGE(PG8_SB(0, 0), b2, voffB); PG8_STAGE(PG8_SB(0, 1), b2 + hstep, voffB); PG8_STAGE(PG8_SA(0, 0), a2, voffA);
            PG8_WAIT_V(8); PG8_WAIT_L(0); PG8_BAR; PG8_MMA(1, 0, At, B0); PG8_MMA(1, 1, At, B1); PG8_BAR; PG8_SCHED;
            PG8_LDB(B0, 1, 0); PG8_LDB(B1, 1, 1); PG8_SCHED; PG8_LDA(At, 1, 0); PG8_STAGE(PG8_SA(0, 1), a2 + hstep, voffA);
            PG8_WAIT_V(8); PG8_WAIT_L(0); PG8_BAR; PG8_MMA(0, 0, At, B0); PG8_MMA(0, 1, At, B1); PG8_BAR; PG8_SCHED;
            PG8_LDA(At, 1, 1); PG8_STAGE(PG8_SB(1, 0), b3, voffB); PG8_STAGE(PG8_SB(1, 1), b3 + hstep, voffB); PG8_STAGE(PG8_SA(1, 0), a3, voffA);
            PG8_WAIT_V(8); PG8_WAIT_L(0); PG8_BAR; PG8_MMA(1, 0, At, B0); PG8_MMA(1, 1, At, B1); PG8_BAR; PG8_SCHED;
            } else {
            PG8_LDB(B0, 0, 0); PG8_SCHED; PG8_LDA(At, 0, 0); PG8_STAGE(PG8_SA(1, 1), a1 + hstep, voffA);
            PG8_WAIT_L(8); PG8_BAR; PG8_WAIT_L(0); PG8_MMA(0, 0, At, B0); PG8_BAR; PG8_SCHED;
            PG8_LDB(B1, 0, 1); PG8_STAGE(PG8_SB(0, 0), b2, voffB);
            PG8_BAR; PG8_WAIT_L(0); PG8_MMA(0, 1, At, B1); PG8_BAR;
            PG8_LDA(At, 0, 1); PG8_STAGE(PG8_SA(0, 0), a2, voffA);
            PG8_BAR; PG8_WAIT_L(0); PG8_MMA(1, 0, At, B0); PG8_BAR; PG8_SCHED;
            PG8_STAGE(PG8_SB(0, 1), b2 + hstep, voffB);
            PG8_WAIT_V(6); PG8_BAR; PG8_MMA(1, 1, At, B1); PG8_BAR;
            PG8_LDB(B0, 1, 0); PG8_SCHED; PG8_LDA(At, 1, 0); PG8_STAGE(PG8_SA(0, 1), a2 + hstep, voffA);
            PG8_WAIT_L(8); PG8_BAR; PG8_WAIT_L(0); PG8_MMA(0, 0, At, B0); PG8_BAR; PG8_SCHED;
            PG8_LDB(B1, 1, 1); PG8_STAGE(PG8_SB(1, 0), b3, voffB);
            PG8_BAR; PG8_WAIT_L(0); PG8_MMA(0, 1, At, B1); PG8_BAR;
            PG8_LDA(At, 1, 1); PG8_STAGE(PG8_SA(1, 0), a3, voffA);
            PG8_BAR; PG8_WAIT_L(0); PG8_MMA(1, 0, At, B0); PG8_BAR; PG8_SCHED;
            PG8_STAGE(PG8_SB(1, 1), b3 + hstep, voffB);
            PG8_WAIT_V(6); PG8_BAR; PG8_MMA(1, 1, At, B1); PG8_BAR;
            }
        }
        if constexpr (ALIGN_EPI) { if (wr == 0) PG8_BAR; }
        if constexpr (!Epi::AFTER_DRAIN) { E(acc, cur, wr, wc, fr, fq); S.done(cur); }
        if (!has_next) break;
#pragma unroll
        for (int a = 0; a < 2; ++a)
#pragma unroll
            for (int b = 0; b < 2; ++b)
#pragma unroll
                for (int m = 0; m < 4; ++m)
#pragma unroll
                    for (int n = 0; n < 2; ++n) acc[a][b][m][n] = (f32x4){0.f, 0.f, 0.f, 0.f};
        cur = nxt; cA = nA; cB = nB; ++ui;
        if constexpr (ALIGN_EPI) { if (wr == 1) PG8_BAR; }
    }
    PG8_WAIT_V(0);
    if constexpr (!ALIGN_EPI) { if (wr == 0) PG8_BAR; }
    PG8_BAR;
    if constexpr (Epi::AFTER_DRAIN) { E.fused(acc, cur, wr, wc, fr, fq, lds, wid, lane); S.done(cur); }
#undef PG8_SA
#undef PG8_SB
#undef PG8_STAGE
#undef PG8_LDA
#undef PG8_LDB
#undef PG8_MMA
#undef PG8_WAIT_V
#undef PG8_WAIT_L
#undef PG8_BAR
#undef PG8_SCHED
}
}

#define LAS __attribute__((address_space(3)))
typedef pg8::bf16_t bf16_t;
typedef pg8::bf16x8 bf16x8;
typedef pg8::f32x4 f32x4;
typedef pg8::u32x4 u32x4;
typedef float f32x16 __attribute__((ext_vector_type(16)));
typedef unsigned u32x2 __attribute__((ext_vector_type(2)));

constexpr int D = 1024, NB = 8, SEQ = 2048, M = NB * SEQ, FF = 4096, INC = 3328, HGW = 512, NMOD6 = 6 * D;
constexpr float EPS = 1e-6f;
constexpr size_t MiB = 1u << 20;
constexpr size_t WS_CTL = 0, CTL_BYTES = 1 * MiB;
constexpr size_t CT_COND = 0, CT_ROWSS = 196608, CT_LBT = 458752;
constexpr size_t WS_WIN = 1 * MiB, WS_WOUT = 14 * MiB, WS_W1 = 18 * MiB, WS_W2 = 34 * MiB;
constexpr size_t WS_ABUF = 50 * MiB;
constexpr size_t WS_QH = 82 * MiB, WS_LF = 98 * MiB, WS_VH = 130 * MiB, WS_GH = 146 * MiB, WS_AQ = 162 * MiB, WS_AK = 178 * MiB, WS_VT = 182 * MiB;
constexpr size_t WS_ST = 186 * MiB, WS_G = 250 * MiB, WS_RSP = 251 * MiB, WS_END = 252 * MiB;
constexpr size_t WS_YRAW1 = 82 * MiB, WS_U = 82 * MiB, WS_YRAW2 = 210 * MiB;
constexpr int LDS_BYTES = 147456;

__device__ __forceinline__ float bf2f(unsigned short h) { return __uint_as_float(((unsigned)h) << 16); }
__device__ __forceinline__ float bflo(unsigned w) { return __uint_as_float(w << 16); }
__device__ __forceinline__ float bfhi(unsigned w) { return __uint_as_float(w & 0xffff0000u); }
__device__ __forceinline__ unsigned pk2(float lo, float hi) { return pg8::cvt_pk_bf16(lo, hi); }
__device__ __forceinline__ unsigned short f2bf(float f) { return (unsigned short)(pg8::cvt_pk_bf16(f, 0.f) & 0xffffu); }
__device__ __forceinline__ float wave_sum(float v) {
#pragma unroll
    for (int o = 1; o < 64; o <<= 1) v += __shfl_xor(v, o);
    return v;
}
__device__ __forceinline__ int otid() { int t = threadIdx.x; asm volatile("" : "+v"(t)); return t; }
__device__ __forceinline__ float fexp(float x) { return __builtin_amdgcn_exp2f(x * 1.4426950408889634f); }
__device__ __forceinline__ float siluf(float x) { return x * __builtin_amdgcn_rcpf(1.f + fexp(-x)); }

struct EpiIn {
    static constexpr bool PERM = true, AFTER_DRAIN = false;
    bf16_t *Qh, *LF, *Vh, *Gh, *AQ, *AK, *VT; const float* lbt;
    __device__ __forceinline__ void operator()(const f32x4 (&acc)[2][2][4][2], const pg8::Unit& u, int wr, int wc, int fr, int fq) const {
        const int row0 = u.pm * 256 + wr * 64 + fr;
        const int pn = u.pn, grp = pn >> 1;
#pragma unroll
        for (int bj = 0; bj < 2; ++bj) {
            const int colt = (pn & 1) * 256 + bj * 128 + wc * 32 + 8 * fq;
            if (pn == 12) {
                const int cc = wc * 32 + 8 * fq;
                if (bj == 0) {
#pragma unroll
                    for (int ai = 0; ai < 2; ++ai)
#pragma unroll
                        for (int m = 0; m < 4; ++m) { const int row = row0 + ai * 128 + m * 16; const f32x4 v0 = acc[ai][bj][m][0], v1 = acc[ai][bj][m][1];
                            u32x4 w; w.x = pk2(v0[0], v0[1]); w.y = pk2(v0[2], v0[3]); w.z = pk2(v1[0], v1[1]); w.w = pk2(v1[2], v1[3]);
                            *(u32x4*)(AK + (size_t)row * 128 + cc) = w; }
                } else {
                    const int kvh = cc >> 6, d0 = cc & 63;
#pragma unroll
                    for (int ai = 0; ai < 2; ++ai)
#pragma unroll
                        for (int m = 0; m < 4; ++m) { const int row = row0 + ai * 128 + m * 16; const int b = row >> 11, s = row & 2047;
                            bf16_t* vp = VT + ((size_t)((b * 2 + kvh) * 64 + d0)) * 2048 + s;
#pragma unroll
                            for (int n = 0; n < 2; ++n)
#pragma unroll
                                for (int i = 0; i < 4; ++i) vp[(size_t)(4 * n + i) * 2048] = f2bf(acc[ai][bj][m][n][i]); }
                }
                continue;
            }
            bf16_t* dst; int mode;
            if (grp == 0) { dst = Qh; mode = 1; } else if (grp == 1) { dst = LF; mode = 2; } else if (grp == 2) { dst = LF + (size_t)M * HGW; mode = 2; }
            else if (grp == 3) { dst = Vh; mode = 0; } else if (grp == 4) { dst = Gh; mode = 1; } else { dst = AQ; mode = 0; }
            f32x4 lb0 = {0.f, 0.f, 0.f, 0.f}, lb1 = {0.f, 0.f, 0.f, 0.f};
            if (mode == 2) { lb0 = *(const f32x4*)(lbt + colt); lb1 = *(const f32x4*)(lbt + colt + 4); }
#pragma unroll
            for (int ai = 0; ai < 2; ++ai)
#pragma unroll
                for (int m = 0; m < 4; ++m) { const int row = row0 + ai * 128 + m * 16; f32x4 v0 = acc[ai][bj][m][0], v1 = acc[ai][bj][m][1];
                    if (mode == 1) {
#pragma unroll
                        for (int i = 0; i < 4; ++i) { v0[i] = siluf(v0[i]); v1[i] = siluf(v1[i]); }
                    } else if (mode == 2) {
#pragma unroll
                        for (int i = 0; i < 4; ++i) {
                            { const float z = v0[i], lb = lb0[i]; const float ls = fminf(z, 0.f) - __logf(1.f + fexp(-fabsf(z))); v0[i] = lb > 0.f ? __logf(lb + (1.f - lb) * fexp(ls)) : ls; }
                            { const float z = v1[i], lb = lb1[i]; const float ls = fminf(z, 0.f) - __logf(1.f + fexp(-fabsf(z))); v1[i] = lb > 0.f ? __logf(lb + (1.f - lb) * fexp(ls)) : ls; }
                        }
                    }
                    u32x4 w; w.x = pk2(v0[0], v0[1]); w.y = pk2(v0[2], v0[3]); w.z = pk2(v1[0], v1[1]); w.w = pk2(v1[2], v1[3]);
                    *(u32x4*)(dst + (size_t)row * HGW + colt) = w; }
        }
    }
};
struct EpiRaw {
    static constexpr bool PERM = true, AFTER_DRAIN = false;
    bf16_t* Y; float* rowss;
    __device__ __forceinline__ void operator()(const f32x4 (&acc)[2][2][4][2], const pg8::Unit& u, int wr, int wc, int fr, int fq) const {
        const int row0 = u.pm * 256 + wr * 64 + fr, col0 = u.pn * 256 + wc * 32 + 8 * fq;
#pragma unroll
        for (int ai = 0; ai < 2; ++ai)
#pragma unroll
            for (int m = 0; m < 4; ++m) { const int row = row0 + ai * 128 + m * 16; float s = 0.f;
#pragma unroll
                for (int bj = 0; bj < 2; ++bj) { const f32x4 v0 = acc[ai][bj][m][0], v1 = acc[ai][bj][m][1];
                    s += (v0[0] * v0[0] + v0[1] * v0[1]) + (v0[2] * v0[2] + v0[3] * v0[3]) + (v1[0] * v1[0] + v1[1] * v1[1]) + (v1[2] * v1[2] + v1[3] * v1[3]);
                    u32x4 w; w.x = pk2(v0[0], v0[1]); w.y = pk2(v0[2], v0[3]); w.z = pk2(v1[0], v1[1]); w.w = pk2(v1[2], v1[3]);
                    *(u32x4*)(Y + (size_t)row * D + col0 + bj * 128) = w; }
                s += __shfl_xor(s, 16); s += __shfl_xor(s, 32);
                if (fq == 0) rowss[(size_t)row * 16 + u.pn * 4 + wc] = s; }
    }
};
struct EpiRelu2 {
    static constexpr bool PERM = true, AFTER_DRAIN = false;
    bf16_t* U;
    __device__ __forceinline__ void operator()(const f32x4 (&acc)[2][2][4][2], const pg8::Unit& u, int wr, int wc, int fr, int fq) const {
        const int row0 = u.pm * 256 + wr * 64 + fr, col0 = u.pn * 256 + wc * 32 + 8 * fq;
#pragma unroll
        for (int ai = 0; ai < 2; ++ai)
#pragma unroll
            for (int m = 0; m < 4; ++m) { const int row = row0 + ai * 128 + m * 16;
#pragma unroll
                for (int bj = 0; bj < 2; ++bj) { f32x4 v0 = acc[ai][bj][m][0], v1 = acc[ai][bj][m][1];
#pragma unroll
                    for (int i = 0; i < 4; ++i) { const float a = fmaxf(v0[i], 0.f), b = fmaxf(v1[i], 0.f); v0[i] = a * a; v1[i] = b * b; }
                    u32x4 w; w.x = pk2(v0[0], v0[1]); w.y = pk2(v0[2], v0[3]); w.z = pk2(v1[0], v1[1]); w.w = pk2(v1[2], v1[3]);
                    *(u32x4*)(U + (size_t)row * FF + col0 + bj * 128) = w; } }
    }
};

__device__ __forceinline__ void transpose_item(const float* W, int K, int N, bf16_t* WT, LAS float* scr, int item, int lane) {
    const int nblk = N / 32, kb = item / nblk, nb = item % nblk, k0 = 64 * kb, n0 = 32 * nb;
#pragma unroll 8
    for (int i = 0; i < 32; ++i) { const int kk = 2 * i + (lane >> 5); scr[kk * 33 + (lane & 31)] = W[(size_t)(k0 + kk) * N + n0 + (lane & 31)]; }
    asm volatile("s_waitcnt lgkmcnt(0)" ::: "memory");
    const int c = lane & 7;
#pragma unroll
    for (int j = 0; j < 4; ++j) { const int n = (lane >> 3) + 8 * j; const LAS float* s = scr + (8 * c) * 33 + n;
        u32x4 o; o.x = pk2(s[0 * 33], s[1 * 33]); o.y = pk2(s[2 * 33], s[3 * 33]); o.z = pk2(s[4 * 33], s[5 * 33]); o.w = pk2(s[6 * 33], s[7 * 33]);
        *(u32x4*)(WT + (size_t)(n0 + n) * K + k0 + 8 * c) = o; }
    asm volatile("s_waitcnt lgkmcnt(0)" ::: "memory");
}

struct Args {
    const float *x, *c, *w_ada, *ada_bias, *lb_logits, *pre_mix, *post_mix, *w_in, *w_out, *hg_gain, *q_gain, *k_gain, *ao_gain, *pre_ff, *post_ff, *w_ff1, *w_ff2;
    float* out; unsigned char* ws; int stop_at, stop_l;
};

template <bool DBG = false>
__device__ __forceinline__ void row_phase(const float* xin, float* xout, const bf16_t* yraw, const float* rowss, const float* post, const float* cond, const float* biasg  , int gidx,
                                          bf16_t* hout, const float* pre, const float* biash  , int shidx, int scidx) {
    const int tid = otid(), lane = tid & 63, wave = tid >> 6;
    const int gw = blockIdx.x * 8 + wave, NGW = gridDim.x * 8;
    const int RPW = (M + NGW - 1) / NGW, rbeg = gw * RPW, rend = (rbeg + RPW < M) ? (rbeg + RPW) : M;
    int bcur = -1;
    f32x4 Gm[4], Am[4], Bm[4];
    f32x4 xn[4]; u32x2 yn[4]; f32x4 pn[4];
#pragma unroll
    for (int j = 0; j < 4; ++j) { xn[j] = (f32x4){0.f, 0.f, 0.f, 0.f}; yn[j] = (u32x2){0u, 0u}; pn[j] = (f32x4){0.f, 0.f, 0.f, 0.f}; Gm[j] = Am[j] = Bm[j] = (f32x4){0.f, 0.f, 0.f, 0.f}; }
#define RP_LOAD(rr) do { _Pragma("unroll") for (int j = 0; j < 4; ++j) { xn[j] = *(const f32x4*)(xin + (size_t)(rr) * D + 256 * j + 4 * lane); \
        if (yraw) { yn[j] = *(const u32x2*)(yraw + (size_t)(rr) * D + 256 * j + 4 * lane); pn[j] = *(const f32x4*)(rowss + (size_t)(rr) * 16 + 4 * j); } } } while (0)
    if (rbeg < rend) RP_LOAD(rbeg);
#pragma unroll 1
    for (int r = rbeg; r < rend; ++r) {
        f32x4 xv[4]; u32x2 yw[4]; f32x4 pv[4];
#pragma unroll
        for (int j = 0; j < 4; ++j) { xv[j] = xn[j]; yw[j] = yn[j]; pv[j] = pn[j]; }
        if (r + 1 < rend) RP_LOAD(r + 1);
        const int b = r >> 11;
        if (b != bcur) { bcur = b;
#pragma unroll
            for (int j = 0; j < 4; ++j) { const int c = 256 * j + 4 * lane;
                if (yraw) { const f32x4 pg = *(const f32x4*)(post + c); const f32x4 gc = *(const f32x4*)(cond + (size_t)b * NMOD6 + gidx * D + c), gb = *(const f32x4*)(biasg + gidx * D + c);
                    Gm[j] = (gc + gb) * pg; }
                if (hout) { const f32x4 pg = *(const f32x4*)(pre + c);
                    const f32x4 sc = *(const f32x4*)(cond + (size_t)b * NMOD6 + scidx * D + c), sb = *(const f32x4*)(biash + scidx * D + c);
                    const f32x4 sh = *(const f32x4*)(cond + (size_t)b * NMOD6 + shidx * D + c), hb = *(const f32x4*)(biash + shidx * D + c);
                    Am[j] = pg * (sc + sb + 1.f); Bm[j] = sh + hb; } } }
        if (yraw) {
            float ssum = 0.f;
#pragma unroll
            for (int q = 0; q < 4; ++q) ssum += (pv[q][0] + pv[q][1]) + (pv[q][2] + pv[q][3]);
            const float rs = rsqrtf(ssum * (1.f / D) + EPS);
#pragma unroll
            for (int j = 0; j < 4; ++j) { const int c = 256 * j + 4 * lane;
                xv[j][0] += Gm[j][0] * (bflo(yw[j].x) * rs); xv[j][1] += Gm[j][1] * (bfhi(yw[j].x) * rs);
                xv[j][2] += Gm[j][2] * (bflo(yw[j].y) * rs); xv[j][3] += Gm[j][3] * (bfhi(yw[j].y) * rs);
                *(f32x4*)(xout + (size_t)r * D + c) = xv[j]; }
        }
        if (hout) {
            float s = 0.f;
#pragma unroll
            for (int j = 0; j < 4; ++j) s += (xv[j][0] * xv[j][0] + xv[j][1] * xv[j][1]) + (xv[j][2] * xv[j][2] + xv[j][3] * xv[j][3]);
            const float rs2 = rsqrtf(wave_sum(s) * (1.f / D) + EPS);
#pragma unroll
            for (int j = 0; j < 4; ++j) { const int c = 256 * j + 4 * lane;
                float h[4];
#pragma unroll
                for (int i = 0; i < 4; ++i) h[i] = xv[j][i] * rs2 * Am[j][i] + Bm[j][i];
                u32x2 w; w.x = pk2(h[0], h[1]); w.y = pk2(h[2], h[3]);
                *(u32x2*)(hout + (size_t)r * D + c) = w; }
        }
    }
#undef RP_LOAD
}

__device__ __forceinline__ void attn_prep(bf16_t* AQ, bf16_t* AK, const float* qg, const float* kg) {
    const int tid = otid(), lane = tid & 63, wave = tid >> 6;
    const int gw = blockIdx.x * 8 + wave, NGW = gridDim.x * 8;
    const float invf = __builtin_amdgcn_exp2f(-(float)(lane & 15) * (13.287712379549449f / 16.f));
    const float qgl = qg[lane], kgl = kg[lane];
    constexpr float QSCALE = 0.125f * 1.4426950408889634f;
    unsigned short xn[10];
#pragma unroll
    for (int h = 0; h < 10; ++h) xn[h] = 0;
    if (gw < M) {
#pragma unroll
        for (int h = 0; h < 10; ++h) xn[h] = (h < 8) ? AQ[(size_t)gw * 512 + h * 64 + lane] : AK[(size_t)gw * 128 + (h - 8) * 64 + lane]; }
#pragma unroll 1
    for (int r = gw; r < M; r += NGW) {
        float x[10];
#pragma unroll
        for (int h = 0; h < 10; ++h) x[h] = bf2f(xn[h]);
        const int rn = r + NGW;
        if (rn < M) {
#pragma unroll
            for (int h = 0; h < 10; ++h) xn[h] = (h < 8) ? AQ[(size_t)rn * 512 + h * 64 + lane] : AK[(size_t)rn * 128 + (h - 8) * 64 + lane]; }
        const int s = r & 2047; const float pos = (float)((lane >> 5) ? (s & 63) : (s >> 6));
        const float ang = pos * invf; const float cs = __cosf(ang), sn = __sinf(ang);
#pragma unroll
        for (int h = 0; h < 10; ++h) {
            const float rs = rsqrtf(wave_sum(x[h] * x[h]) * (1.f / 64.f) + EPS);
            const float y = x[h] * rs * (h < 8 ? qgl : kgl);
            const float pr = __shfl_xor(y, 16);
            float o = (lane & 16) ? (y * cs + pr * sn) : (y * cs - pr * sn);
            if (h < 8) o *= QSCALE;
            x[h] = o;
        }
#pragma unroll
        for (int h = 0; h < 10; ++h) { bf16_t* p = (h < 8) ? (AQ + (size_t)r * 512 + h * 64 + lane) : (AK + (size_t)r * 128 + (h - 8) * 64 + lane); *p = f2bf(x[h]); }
    }
}

template <bool fixm>
__device__ __forceinline__ void attn_units(LAS unsigned char* lds, const bf16_t* QP, const bf16_t* KP, const bf16_t* VT, bf16_t* ymix, const float* og, bf16_t* UT, const float* G, const float sinit);
__device__ __forceinline__ void attn_phase(LAS unsigned char* lds, const bf16_t* QP, const bf16_t* KP, const bf16_t* VT, bf16_t* ymix, const float* og, bf16_t* UT, const float* G, const float* qg, const float* kg) {
    const int tid = otid(), wid = tid >> 6, lane = tid & 63, r32 = lane & 31, hi = lane >> 5;
    float mq = fabsf(qg[lane]), mk = fabsf(kg[lane]);
#pragma unroll
    for (int o = 1; o < 64; o <<= 1) { mq = fmaxf(mq, __shfl_xor(mq, o)); mk = fmaxf(mk, __shfl_xor(mk, o)); }
    const float B2 = 8.f * mq * mk * 1.4426950408889634f * 1.01f;
    const bool fixm0 = __builtin_amdgcn_readfirstlane((int)(B2 <= 40.f)) != 0;
    if (fixm0) attn_units<true>(lds, QP, KP, VT, ymix, og, UT, G, -B2); else attn_units<false>(lds, QP, KP, VT, ymix, og, UT, G, 0.f);
}
template <bool fixm>
__device__ __forceinline__ void attn_units(LAS unsigned char* lds, const bf16_t* QP, const bf16_t* KP, const bf16_t* VT, bf16_t* ymix, const float* og, bf16_t* UT, const float* G, const float sinit) {
#pragma unroll 1
    for (int unit = blockIdx.x; unit < 256; unit += gridDim.x) {
        const int tid = otid(), wid = tid >> 6, lane = tid & 63, r32 = lane & 31, hi = lane >> 5;
        const int skey = tid >> 3, sch = tid & 7;
        const unsigned soff = skey * 144 + sch * 16;
        const int b = unit >> 5, kvh = (unit >> 4) & 1, qb = unit & 15;
        const int head = kvh * 4 + (wid >> 1), tok0 = qb * 128 + (wid & 1) * 64;
        bf16x8 qf[2][4];
#pragma unroll
        for (int qs = 0; qs < 2; ++qs) { const bf16_t* qp = QP + (size_t)(b * 2048 + tok0 + 32 * qs + r32) * 512 + head * 64 + 8 * hi;
#pragma unroll
            for (int ks = 0; ks < 4; ++ks) qf[qs][ks] = *(const bf16x8*)(qp + 16 * ks); }
        const bf16_t* kg = KP + (size_t)(b * 2048 + skey) * 128 + kvh * 64 + 8 * sch;
        const bf16_t* vg = VT + ((size_t)((b * 2 + kvh) * 64 + skey)) * 2048 + 8 * sch;
        u32x4 kr = *(const u32x4*)kg, vr = *(const u32x4*)vg;
        *(LAS u32x4*)(lds + soff) = kr; *(LAS u32x4*)(lds + 18432 + soff) = vr;
        __syncthreads();
        f32x16 o[2][2];
#pragma unroll
        for (int qs = 0; qs < 2; ++qs)
#pragma unroll
            for (int i = 0; i < 16; ++i) { o[qs][0][i] = 0.f; o[qs][1][i] = 0.f; }
        float mrun[2] = {-INFINITY, -INFINITY}, lrun[2] = {0.f, 0.f};
        const int h2item = blockIdx.x * 512 + tid; const bool h2on = (unit == (int)blockIdx.x) && (h2item < 64 * 2048);
        bf16_t* hp = UT; const float* gp = G;
        LAS unsigned char* hsl = lds + 36864 + tid * 32;
        LAS unsigned char* dsl = lds + 53248 + wid * 1024;
        if (h2on) { const int seq = h2item >> 11, rem = h2item & 2047, e = rem >> 4, d0 = (rem & 15) * 8;
            hp = UT + (((size_t)seq * 32) * 128 + e) * 128 + d0; gp = G + (size_t)seq * 32 * 128 + d0;
            *(LAS f32x4*)(hsl) = (f32x4){0.f, 0.f, 0.f, 0.f}; *(LAS f32x4*)(hsl + 16) = (f32x4){0.f, 0.f, 0.f, 0.f};
            __builtin_amdgcn_global_load_lds((const unsigned*)hp, (LAS unsigned*)(dsl), 16, 0, 0);
            __builtin_amdgcn_global_load_lds((const unsigned*)gp, (LAS unsigned*)(dsl + 8192), 16, 0, 0);
            __builtin_amdgcn_global_load_lds((const unsigned*)(gp + 4), (LAS unsigned*)(dsl + 16384), 16, 0, 0);
            asm volatile("s_waitcnt vmcnt(0)" ::: "memory"); }
#pragma unroll 1
        for (int j = 0; j < 32; ++j) {
            const LAS unsigned char* kb = lds + (j & 1) * 9216; const LAS unsigned char* vb = lds + 18432 + (j & 1) * 9216;
            if (h2on) {
                asm volatile("s_waitcnt vmcnt(0)" ::: "memory");
                const u32x4 huw = *(const LAS u32x4*)(dsl + lane * 16); const f32x4 hg0 = *(const LAS f32x4*)(dsl + 8192 + lane * 16), hg1 = *(const LAS f32x4*)(dsl + 16384 + lane * 16);
                f32x4 s0v = *(const LAS f32x4*)(hsl), s1v = *(const LAS f32x4*)(hsl + 16);
                u32x4 ow; ow.x = pk2(s0v[0], s0v[1]); ow.y = pk2(s0v[2], s0v[3]); ow.z = pk2(s1v[0], s1v[1]); ow.w = pk2(s1v[2], s1v[3]);
                *(u32x4*)(hp + (size_t)j * 16384) = ow;
                s0v[0] = hg0[0] * s0v[0] + bflo(huw.x); s0v[1] = hg0[1] * s0v[1] + bfhi(huw.x); s0v[2] = hg0[2] * s0v[2] + bflo(huw.y); s0v[3] = hg0[3] * s0v[3] + bfhi(huw.y);
                s1v[0] = hg1[0] * s1v[0] + bflo(huw.z); s1v[1] = hg1[1] * s1v[1] + bfhi(huw.z); s1v[2] = hg1[2] * s1v[2] + bflo(huw.w); s1v[3] = hg1[3] * s1v[3] + bfhi(huw.w);
                *(LAS f32x4*)(hsl) = s0v; *(LAS f32x4*)(hsl + 16) = s1v;
                asm volatile("s_waitcnt lgkmcnt(0)" ::: "memory");
                if (j + 1 < 32) {
                    __builtin_amdgcn_global_load_lds((const unsigned*)(hp + (size_t)(j + 1) * 16384), (LAS unsigned*)(dsl), 16, 0, 0);
                    __builtin_amdgcn_global_load_lds((const unsigned*)(gp + (j + 1) * 128), (LAS unsigned*)(dsl + 8192), 16, 0, 0);
                    __builtin_amdgcn_global_load_lds((const unsigned*)(gp + (j + 1) * 128 + 4), (LAS unsigned*)(dsl + 16384), 16, 0, 0); }
            }
            if (j + 1 < 32) { kr = *(const u32x4*)(kg + (size_t)(j + 1) * 64 * 128); vr = *(const u32x4*)(vg + (j + 1) * 64); }
#pragma unroll
            for (int mb = 0; mb < 2; ++mb) {
                f32x16 s[2];
#pragma unroll
                for (int i = 0; i < 16; ++i) { s[0][i] = sinit; s[1][i] = sinit; }
#pragma unroll
                for (int ks = 0; ks < 4; ++ks) {
                    const bf16x8 a0 = *(const LAS bf16x8*)(kb + (32 * mb + r32) * 144 + (16 * ks + 8 * hi) * 2);
                    s[0] = __builtin_amdgcn_mfma_f32_32x32x16_bf16(a0, qf[0][ks], s[0], 0, 0, 0);
                    s[1] = __builtin_amdgcn_mfma_f32_32x32x16_bf16(a0, qf[1][ks], s[1], 0, 0, 0);
                }
#pragma unroll
                for (int qs = 0; qs < 2; ++qs) {
                    if (fixm) {
                        float ps0 = 0.f, ps1 = 0.f;
#pragma unroll
                        for (int i = 0; i < 8; ++i) { s[qs][i] = __builtin_amdgcn_exp2f(s[qs][i]); s[qs][8 + i] = __builtin_amdgcn_exp2f(s[qs][8 + i]); ps0 += s[qs][i]; ps1 += s[qs][8 + i]; }
                        lrun[qs] += ps0 + ps1;
                    } else {
                        float mx = s[qs][0];
#pragma unroll
                        for (int i = 1; i < 16; ++i) mx = fmaxf(mx, s[qs][i]);
                        mx = fmaxf(mx, __shfl_xor(mx, 32));
                        const float mnew = fmaxf(mrun[qs], mx); const float alpha = __builtin_amdgcn_exp2f(mrun[qs] - mnew); mrun[qs] = mnew;
                        float ps = 0.f;
#pragma unroll
                        for (int i = 0; i < 16; ++i) { s[qs][i] = __builtin_amdgcn_exp2f(s[qs][i] - mnew); ps += s[qs][i]; }
                        lrun[qs] = lrun[qs] * alpha + ps;
#pragma unroll
                        for (int i = 0; i < 16; ++i) { o[qs][0][i] *= alpha; o[qs][1][i] *= alpha; }
                    }
                }
#pragma unroll
                for (int u = 0; u < 2; ++u) {
                    const int keybase = 32 * mb + 16 * u;
                    const u32x2 l0 = *(const LAS u32x2*)(vb + r32 * 144 + (keybase + 4 * hi) * 2), h0 = *(const LAS u32x2*)(vb + r32 * 144 + (keybase + 8 + 4 * hi) * 2);
                    const u32x2 l1 = *(const LAS u32x2*)(vb + (32 + r32) * 144 + (keybase + 4 * hi) * 2), h1 = *(const LAS u32x2*)(vb + (32 + r32) * 144 + (keybase + 8 + 4 * hi) * 2);
                    u32x4 a0w; a0w.x = l0.x; a0w.y = l0.y; a0w.z = h0.x; a0w.w = h0.y;
                    u32x4 a1w; a1w.x = l1.x; a1w.y = l1.y; a1w.z = h1.x; a1w.w = h1.y;
#pragma unroll
                    for (int qs = 0; qs < 2; ++qs) {
                        u32x4 pw;
                        pw.x = pk2(s[qs][8 * u + 0], s[qs][8 * u + 1]); pw.y = pk2(s[qs][8 * u + 2], s[qs][8 * u + 3]);
                        pw.z = pk2(s[qs][8 * u + 4], s[qs][8 * u + 5]); pw.w = pk2(s[qs][8 * u + 6], s[qs][8 * u + 7]);
                        const bf16x8 pb = __builtin_bit_cast(bf16x8, pw);
                        o[qs][0] = __builtin_amdgcn_mfma_f32_32x32x16_bf16(__builtin_bit_cast(bf16x8, a0w), pb, o[qs][0], 0, 0, 0);
                        o[qs][1] = __builtin_amdgcn_mfma_f32_32x32x16_bf16(__builtin_bit_cast(bf16x8, a1w), pb, o[qs][1], 0, 0, 0);
                    }
                }
                __builtin_amdgcn_sched_barrier(0);
            }
            if (j + 1 < 32) { const unsigned nb = ((j + 1) & 1) * 9216; *(LAS u32x4*)(lds + nb + soff) = kr; *(LAS u32x4*)(lds + 18432 + nb + soff) = vr; }
            __syncthreads();
        }
        f32x4 gv[2][4];
#pragma unroll
        for (int q4 = 0; q4 < 4; ++q4) { gv[0][q4] = *(const f32x4*)(og + 8 * q4 + 4 * hi); gv[1][q4] = *(const f32x4*)(og + 32 + 8 * q4 + 4 * hi); }
#pragma unroll
        for (int qs = 0; qs < 2; ++qs) {
            const float l = lrun[qs] + __shfl_xor(lrun[qs], 32); const float inv = 1.f / l;
            float ss = 0.f;
#pragma unroll
            for (int i = 0; i < 16; ++i) { o[qs][0][i] *= inv; o[qs][1][i] *= inv; ss += o[qs][0][i] * o[qs][0][i] + o[qs][1][i] * o[qs][1][i]; }
            ss += __shfl_xor(ss, 32);
            const float rs = rsqrtf(ss * (1.f / 64.f) + EPS);
            bf16_t* yp = ymix + (size_t)(b * 2048 + tok0 + 32 * qs + r32) * D + 512 + head * 64;
#pragma unroll
            for (int q4 = 0; q4 < 4; ++q4) {
                { const int d0 = 8 * q4 + 4 * hi; const f32x4 g = gv[0][q4];
                  u32x2 w; w.x = pk2(o[qs][0][4 * q4 + 0] * rs * g[0], o[qs][0][4 * q4 + 1] * rs * g[1]); w.y = pk2(o[qs][0][4 * q4 + 2] * rs * g[2], o[qs][0][4 * q4 + 3] * rs * g[3]); *(u32x2*)(yp + d0) = w; }
                { const int d0 = 32 + 8 * q4 + 4 * hi; const f32x4 g = gv[1][q4];
                  u32x2 w; w.x = pk2(o[qs][1][4 * q4 + 0] * rs * g[0], o[qs][1][4 * q4 + 1] * rs * g[1]); w.y = pk2(o[qs][1][4 * q4 + 2] * rs * g[2], o[qs][1][4 * q4 + 3] * rs * g[3]); *(u32x2*)(yp + d0) = w; }
            }
        }
    }
}

__device__ __forceinline__ void h1_phase(LAS unsigned char* lds, const bf16_t* LF, const bf16_t* Vh, bf16_t* UT, float* G) {
    const int tid = otid(), wid = tid >> 6, lane = tid & 63, fr = lane & 15, fq = lane >> 4;
    const int d = tid & 127, I = tid >> 7;
    LAS float* Ts = (LAS float*)lds; LAS unsigned char* kdT = lds + 2048; LAS unsigned char* vT = lds + 2048 + 18432;
    for (int unit = blockIdx.x; unit < 2048; unit += gridDim.x) {
        const int c = unit & 31, dir = (unit >> 5) & 1, h = (unit >> 6) & 3, n = unit >> 8;
        float beta[16], lf[16]; unsigned short vv[16];
        const bf16_t* lfb = LF + ((size_t)dir * M + (size_t)n * 2048) * HGW + h * 128; const bf16_t* vhb = Vh + (size_t)n * 2048 * HGW + h * 128;
        unsigned bo0 = (unsigned)d * 2u; asm volatile("" : "+v"(bo0));
#pragma unroll
        for (int j = 0; j < 16; ++j) { const int f = 64 * c + 16 * I + j; const int tok = dir ? (2047 - f) : f; const unsigned bo = (unsigned)(tok * (HGW * 2)) + bo0;
            lf[j] = bf2f(*(const bf16_t*)((const char*)lfb + bo)); vv[j] = *(const bf16_t*)((const char*)vhb + bo); }
        float run = 0.f;
#pragma unroll
        for (int j = 0; j < 16; ++j) { run += lf[j]; beta[j] = run; }
        Ts[I * 128 + d] = run;
        __syncthreads();
        const float T0 = Ts[d], T1 = Ts[128 + d], T2 = Ts[256 + d], T3 = Ts[384 + d];
        const float r4 = (T0 + T1) + (T2 + T3);
        const float rI = (I > 0 ? T0 : 0.f) + (I > 1 ? T1 : 0.f) + (I > 2 ? T2 : 0.f);
        const float base = r4 - rI;
        unsigned kw[8], vw[8];
#pragma unroll
        for (int j = 0; j < 8; ++j) {
            const float k0 = (1.f - fexp(lf[2 * j])) * fexp(base - beta[2 * j]), k1 = (1.f - fexp(lf[2 * j + 1])) * fexp(base - beta[2 * j + 1]);
            kw[j] = pk2(k0, k1); vw[j] = (unsigned)vv[2 * j] | ((unsigned)vv[2 * j + 1] << 16); }
        { u32x4 a; a.x = kw[0]; a.y = kw[1]; a.z = kw[2]; a.w = kw[3]; u32x4 bq; bq.x = kw[4]; bq.y = kw[5]; bq.z = kw[6]; bq.w = kw[7];
          *(LAS u32x4*)(kdT + d * 144 + I * 32) = a; *(LAS u32x4*)(kdT + d * 144 + I * 32 + 16) = bq; }
        { u32x4 a; a.x = vw[0]; a.y = vw[1]; a.z = vw[2]; a.w = vw[3]; u32x4 bq; bq.x = vw[4]; bq.y = vw[5]; bq.z = vw[6]; bq.w = vw[7];
          *(LAS u32x4*)(vT + d * 144 + I * 32) = a; *(LAS u32x4*)(vT + d * 144 + I * 32 + 16) = bq; }
        if (I == 0) G[(size_t)unit * 128 + d] = fexp(r4);
        __syncthreads();
        bf16x8 bfr[2];
#pragma unroll
        for (int ks = 0; ks < 2; ++ks) bfr[ks] = *(const LAS bf16x8*)(vT + (16 * wid + fr) * 144 + (32 * ks + 8 * fq) * 2);
        bf16_t* up = UT + ((size_t)unit * 128 + 16 * wid + fr) * 128 + 4 * fq;
#pragma unroll
        for (int mb = 0; mb < 8; ++mb) {
            f32x4 acc = {0.f, 0.f, 0.f, 0.f};
#pragma unroll
            for (int ks = 0; ks < 2; ++ks) { const bf16x8 a = *(const LAS bf16x8*)(kdT + (16 * mb + fr) * 144 + (32 * ks + 8 * fq) * 2);
                acc = __builtin_amdgcn_mfma_f32_16x16x32_bf16(a, bfr[ks], acc, 0, 0, 0); }
            u32x2 w; w.x = pk2(acc[0], acc[1]); w.y = pk2(acc[2], acc[3]);
            *(u32x2*)(up + 16 * mb) = w;
        }
        __syncthreads();
    }
}

__device__ __forceinline__ void h2_phase(bf16_t* UT, const float* G) {
    const int gt = blockIdx.x * 512 + otid(), GN = gridDim.x * 512;
    for (int item = gt + GN; item < 64 * 2048; item += GN) {
        const int seq = item >> 11, rem = item & 2047, e = rem >> 4, d0 = (rem & 15) * 8;
        float S[8];
#pragma unroll
        for (int i = 0; i < 8; ++i) S[i] = 0.f;
#pragma unroll 4
        for (int c = 0; c < 32; ++c) {
            const size_t unit = (size_t)seq * 32 + c;
            bf16_t* p = UT + (unit * 128 + e) * 128 + d0;
            const u32x4 uw = *(const u32x4*)p;
            const f32x4 g0 = *(const f32x4*)(G + unit * 128 + d0), g1 = *(const f32x4*)(G + unit * 128 + d0 + 4);
            u32x4 o; o.x = pk2(S[0], S[1]); o.y = pk2(S[2], S[3]); o.z = pk2(S[4], S[5]); o.w = pk2(S[6], S[7]);
            *(u32x4*)p = o;
            S[0] = g0[0] * S[0] + bflo(uw.x); S[1] = g0[1] * S[1] + bfhi(uw.x); S[2] = g0[2] * S[2] + bflo(uw.y); S[3] = g0[3] * S[3] + bfhi(uw.y);
            S[4] = g1[0] * S[4] + bflo(uw.z); S[5] = g1[1] * S[5] + bfhi(uw.z); S[6] = g1[2] * S[6] + bflo(uw.w); S[7] = g1[3] * S[7] + bfhi(uw.w);
        }
    }
}

constexpr int H3_TS = 0, H3_RED = 2048, H3_RSV = 4096, H3_QT = 4352, H3_QB = 21760, H3_KV = 39168, H3_VT = 82688, H3_P = 101120, H3_END = 110336;
__device__ __forceinline__ void h3_load(int unit, int dir, unsigned bo0, int I, const bf16_t* LF, const bf16_t* Qh, const bf16_t* Vh, unsigned (&lq)[16], unsigned (&vw)[8]) {
    const int c = unit & 31, h = (unit >> 5) & 3, n = unit >> 7;
    const size_t ub = ((size_t)n * 2048 + 64 * c) * HGW + h * 128;
    const bf16_t* lfb = LF + (size_t)dir * M * HGW + ub; const bf16_t* qhb = Qh + ub; const bf16_t* vhb = Vh + ub;
#pragma unroll
    for (int j = 0; j < 16; ++j) { const int t = 16 * I + j; const int p = dir ? (63 - t) : t; const unsigned bo = (unsigned)(p * (HGW * 2)) + bo0;
        lq[j] = (unsigned)*(const bf16_t*)((const char*)lfb + bo) | ((unsigned)*(const bf16_t*)((const char*)qhb + bo) << 16);
        const unsigned v = (unsigned)*(const bf16_t*)((const char*)vhb + bo);
        if (j & 1) vw[j >> 1] |= v << 16; else vw[j >> 1] = v; }
}
__device__ __forceinline__ void h3_phase(LAS unsigned char* lds, const bf16_t* LF, const bf16_t* Qh, const bf16_t* Vh, const bf16_t* Gh, const bf16_t* ST, const float* hgain, bf16_t* ymix) {
    const int tid = otid(), wid = tid >> 6, lane = tid & 63, fr = lane & 15, fq = lane >> 4;
    const int d = tid & 127, I = tid >> 7;
    LAS float* Ts = (LAS float*)(lds + H3_TS); LAS float* red = (LAS float*)(lds + H3_RED); LAS float* rsv = (LAS float*)(lds + H3_RSV);
    LAS unsigned char* qt = lds + H3_QT; LAS unsigned char* qbL = lds + H3_QB; LAS unsigned char* kv = lds + H3_KV; LAS unsigned char* vT = lds + H3_VT; LAS unsigned char* P = lds + H3_P;
    for (int i = tid; i < 9216 / 4; i += 512) ((LAS unsigned*)P)[i] = 0u;
    __syncthreads();
    int ndu = 0;
    for (int u = blockIdx.x; u < 1024; u += gridDim.x) ndu += 2;
    unsigned lqn[16], vwn[8];
#pragma unroll
    for (int j = 0; j < 16; ++j) lqn[j] = 0u;
#pragma unroll
    for (int j = 0; j < 8; ++j) vwn[j] = 0u;
    if (ndu > 0) { unsigned bo0 = (unsigned)d * 2u; asm volatile("" : "+v"(bo0)); h3_load(blockIdx.x, 0, bo0, I, LF, Qh, Vh, lqn, vwn); }
    f32x4 acc[4];
#pragma unroll
    for (int mb = 0; mb < 4; ++mb) acc[mb] = (f32x4){0.f, 0.f, 0.f, 0.f};
#pragma unroll 1
    for (int du = 0; du < ndu; ++du) {
        const int unit = blockIdx.x + (du >> 1) * gridDim.x, dir = du & 1;
        const int c = unit & 31, h = (unit >> 5) & 3, n = unit >> 7;
        unsigned lq[16], vw[8];
#pragma unroll
        for (int j = 0; j < 16; ++j) lq[j] = lqn[j];
#pragma unroll
        for (int j = 0; j < 8; ++j) vw[j] = vwn[j];
#if 0
        if (du + 1 < ndu) { unsigned bo0 = (unsigned)d * 2u; asm volatile("" : "+v"(bo0)); h3_load(blockIdx.x + ((du + 1) >> 1) * gridDim.x, (du + 1) & 1, bo0, I, LF, Qh, Vh, lqn, vwn); }
#else
        { unsigned bo0 = (unsigned)d * 2u; asm volatile("" : "+v"(bo0)); h3_load(unit, dir, bo0, I, LF, Qh, Vh, lq, vw); }
#endif
        const int cs = dir ? (31 - c) : c; const size_t su = ((size_t)((n * 4 + h) * 2 + dir)) * 32 + cs;
        bf16x8 sfr[4];
#pragma unroll
        for (int ks = 0; ks < 4; ++ks) sfr[ks] = *(const bf16x8*)(ST + (su * 128 + 16 * wid + fr) * 128 + 32 * ks + 8 * fq);
        unsigned ghw[8];
#pragma unroll
        for (int j = 0; j < 8; ++j) ghw[j] = 0u;
        if (dir == 1) { unsigned eo = (unsigned)(16 * wid + fr) * 2u; asm volatile("" : "+v"(eo));
            const bf16_t* ghb = Gh + ((size_t)n * 2048 + 64 * c) * HGW + h * 128;
#pragma unroll
            for (int mb = 0; mb < 4; ++mb)
#pragma unroll
                for (int j = 0; j < 4; ++j) { const int p = 16 * mb + 4 * fq + j; const unsigned v = (unsigned)*(const bf16_t*)((const char*)ghb + ((unsigned)(p * (HGW * 2)) + eo));
                    if (j & 1) ghw[2 * mb + (j >> 1)] |= v << 16; else ghw[2 * mb + (j >> 1)] = v; } }
        float beta[16];
        float run = 0.f;
#pragma unroll
        for (int j = 0; j < 16; ++j) { run += bflo(lq[j]); beta[j] = run; }
        Ts[I * 128 + d] = run;
        __syncthreads();
        const float T0 = Ts[d], T1 = Ts[128 + d], T2 = Ts[256 + d];
        const float rI = (I > 0 ? T0 : 0.f) + (I > 1 ? T1 : 0.f) + (I > 2 ? T2 : 0.f);
        const float TI = (I == 0) ? T0 : (I == 1) ? T1 : (I == 2) ? T2 : 0.f;
        const float TI1 = (I == 0) ? T1 : (I == 1) ? T2 : 0.f;
        const float TI2 = (I == 0) ? T2 : 0.f;
        const float e_rI = fexp(rI);
        const float E1 = fexp(TI), E2 = fexp(TI + TI1), E3 = fexp(TI + TI1 + TI2);
        const int vb0 = (I == 0) ? 0 : (I == 1) ? 16 : (I == 2) ? 48 : 96;
        const int vb1 = (I == 0) ? 16 : (I == 1) ? 48 : 96, vb2 = (I == 0) ? 48 : 96;
#pragma unroll
        for (int j = 0; j < 16; ++j) {
            const int t = 16 * I + j;
            const float eb = fexp(beta[j]); const float qe = bfhi(lq[j]) * eb;
            *(LAS unsigned short*)(qt + t * 272 + d * 2) = f2bf(qe);
            *(LAS unsigned short*)(qbL + t * 272 + d * 2) = f2bf(qe * e_rI);
            const float k = 1.f - fexp(bflo(lq[j]));
            const float kd = k * fexp(-beta[j]);
            *(LAS unsigned short*)(kv + (vb0 + t) * 272 + d * 2) = f2bf(kd);
            if (I < 3) *(LAS unsigned short*)(kv + (vb1 + t) * 272 + d * 2) = f2bf(kd * E1);
            if (I < 2) *(LAS unsigned short*)(kv + (vb2 + t) * 272 + d * 2) = f2bf(kd * E2);
            if (I < 1) *(LAS unsigned short*)(kv + (96 + t) * 272 + d * 2) = f2bf(kd * E3);
            if ((j & 3) == 3) __builtin_amdgcn_sched_barrier(0);
        }
        { u32x4 a; a.x = vw[0]; a.y = vw[1]; a.z = vw[2]; a.w = vw[3]; u32x4 bq; bq.x = vw[4]; bq.y = vw[5]; bq.z = vw[6]; bq.w = vw[7];
          *(LAS u32x4*)(vT + d * 144 + I * 32) = a; *(LAS u32x4*)(vT + d * 144 + I * 32 + 16) = bq; }
        __syncthreads();
        for (int blk = wid; blk < 10; blk += 8) {
            const int Ib = (blk < 1) ? 0 : (blk < 3) ? 1 : (blk < 6) ? 2 : 3;
            const int Jb = blk - ((Ib * (Ib + 1)) >> 1);
            const int vbI = (Ib == 0) ? 0 : (Ib == 1) ? 16 : (Ib == 2) ? 48 : 96;
            f32x4 sc = {0.f, 0.f, 0.f, 0.f};
#pragma unroll
            for (int ks = 0; ks < 4; ++ks) {
                const bf16x8 a = *(const LAS bf16x8*)(qt + (16 * Ib + fr) * 272 + (32 * ks + 8 * fq) * 2);
                const bf16x8 bb = *(const LAS bf16x8*)(kv + (vbI + 16 * Jb + fr) * 272 + (32 * ks + 8 * fq) * 2);
                sc = __builtin_amdgcn_mfma_f32_16x16x32_bf16(a, bb, sc, 0, 0, 0);
            }
#pragma unroll
            for (int j = 0; j < 4; ++j) { float v = sc[j]; if (Ib == Jb && fr > 4 * fq + j) v = 0.f;
                *(LAS unsigned short*)(P + (16 * Ib + 4 * fq + j) * 144 + (16 * Jb + fr) * 2) = f2bf(v); }
        }
        __syncthreads();
#pragma unroll
        for (int mb = 0; mb < 4; ++mb) {
            const int p = 16 * mb + fr; const int tr = dir ? (63 - p) : p;
#pragma unroll
            for (int ks = 0; ks < 4; ++ks) { const bf16x8 a = *(const LAS bf16x8*)(qbL + tr * 272 + (32 * ks + 8 * fq) * 2);
                acc[mb] = __builtin_amdgcn_mfma_f32_16x16x32_bf16(a, sfr[ks], acc[mb], 0, 0, 0); }
#pragma unroll
            for (int ks = 0; ks < 2; ++ks) { const bf16x8 a = *(const LAS bf16x8*)(P + tr * 144 + (32 * ks + 8 * fq) * 2);
                const bf16x8 bv = *(const LAS bf16x8*)(vT + (16 * wid + fr) * 144 + (32 * ks + 8 * fq) * 2);
                acc[mb] = __builtin_amdgcn_mfma_f32_16x16x32_bf16(a, bv, acc[mb], 0, 0, 0); }
            __builtin_amdgcn_sched_barrier(0);
        }
        __syncthreads();
        if (dir == 0) continue;
#pragma unroll
        for (int mb = 0; mb < 4; ++mb)
#pragma unroll
            for (int j = 0; j < 4; ++j) { float s = acc[mb][j] * acc[mb][j];
                s += __shfl_xor(s, 1); s += __shfl_xor(s, 2); s += __shfl_xor(s, 4); s += __shfl_xor(s, 8);
                if (fr == 0) red[wid * 64 + 16 * mb + 4 * fq + j] = s; }
        __syncthreads();
        if (tid < 64) { float t = 0.f;
#pragma unroll
            for (int w = 0; w < 8; ++w) t += red[w * 64 + tid];
            rsv[tid] = rsqrtf(t * (1.f / 128.f) + EPS); }
        __syncthreads();
        const int e = 16 * wid + fr; const float ge = hgain[e];
        unsigned eo = (unsigned)e * 2u; asm volatile("" : "+v"(eo));
        bf16_t* ymb = ymix + ((size_t)n * 2048 + 64 * c) * D + h * 128;
#pragma unroll
        for (int mb = 0; mb < 4; ++mb) {
#pragma unroll
            for (int j = 0; j < 4; ++j) { const int p = 16 * mb + 4 * fq + j;
                const unsigned gw2 = ghw[2 * mb + (j >> 1)]; const float y = acc[mb][j] * rsv[p] * ge * ((j & 1) ? bfhi(gw2) : bflo(gw2));
                *(bf16_t*)((char*)ymb + ((unsigned)(p * (D * 2)) + eo)) = f2bf(y); }
            acc[mb] = (f32x4){0.f, 0.f, 0.f, 0.f};
        }
    }
}

#ifdef DIAG
__device__ __forceinline__ void nan_check_bf16(const bf16_t* buf, size_t n, unsigned* flag) {
    const size_t gt = (size_t)blockIdx.x * 512 + otid(), GN = (size_t)gridDim.x * 512; unsigned bad = 0;
#pragma unroll 1
    for (size_t i = gt; i < n / 2; i += GN) { const unsigned w = ((const unsigned*)buf)[i]; if ((w & 0x7f80u) == 0x7f80u || (w & 0x7f800000u) == 0x7f800000u) bad = 1; }
    if (bad) atomicOr(flag, 1u);
}
__device__ __forceinline__ void nan_check_f32(const float* buf, size_t n, unsigned* flag) {
    const size_t gt = (size_t)blockIdx.x * 512 + otid(), GN = (size_t)gridDim.x * 512; unsigned bad = 0;
#pragma unroll 1
    for (size_t i = gt; i < n; i += GN) { const unsigned w = __float_as_uint(buf[i]); if ((w & 0x7f800000u) == 0x7f800000u) bad = 1; }
    if (bad) atomicOr(flag, 1u);
}
#define DCHK_BF(buf, n, slot) nan_check_bf16(buf, n, DIAGW + (slot))
#define DCHK_F(buf, n, slot) nan_check_f32(buf, n, DIAGW + (slot))
#else
#define DCHK_BF(buf, n, slot)
#define DCHK_F(buf, n, slot)
#endif

#ifndef STOP_AT
#define STOP_AT 0
#endif
__device__ __forceinline__ void dump_bf16(const bf16_t* buf, float* out) {
    const size_t gt = (size_t)blockIdx.x * 512 + otid(), GN = (size_t)gridDim.x * 512;
#pragma unroll 1
    for (size_t i = gt; i < (size_t)M * D; i += GN) {
#ifdef DUMP_NANFLAG
        const unsigned short w = buf[i]; out[i] = ((w & 0x7f80u) == 0x7f80u) ? 1000.f : 0.f;
#else
        out[i] = bf2f(buf[i]);
#endif
    }
}
#ifndef STOP_L
#define STOP_L 0
#endif
#define STOPK(k, buf) if (a.stop_at == (k) && l == a.stop_l) { dump_bf16(buf, a.out); return; }
#define XB_TMO      128
#define XB_XCNT(j)  (256  + 64 * (j))
#define XB_XSUB(j)  (1280 + 64 * (j))
#define XB_XGEN(j)  (2304 + 64 * (j))
#define XB_TOP      3328
#define XB_TOPGEN   3392
#define XCD_BAR_WORDS 3456
#define XB_SPIN_CAP (1u << 18)

__device__ __forceinline__ unsigned xb_ld(unsigned* p)              { return __hip_atomic_load(p, __ATOMIC_RELAXED, __HIP_MEMORY_SCOPE_AGENT); }
__device__ __forceinline__ unsigned xb_add(unsigned* p, unsigned v) { return __hip_atomic_fetch_add(p, v, __ATOMIC_RELAXED, __HIP_MEMORY_SCOPE_AGENT); }
__device__ __forceinline__ unsigned xb_xcc_id() { return (unsigned)__builtin_amdgcn_s_getreg((3 << 11) | 20) & 0xFu; }
#define XB_SPIN(cond, bar) do { unsigned _sp = 0; while (cond) { __builtin_amdgcn_s_sleep(1); \
    if ((++_sp & 255u) == 0u) { if (xb_ld(&(bar)[XB_TMO])) break; if (_sp > XB_SPIN_CAP) { atomicAdd(&(bar)[XB_TMO], 1u); break; } } } } while (0)

struct XcdBarrier {
    unsigned* bar; unsigned x;
    volatile LAS unsigned* st;
};

__device__ __forceinline__ XcdBarrier xcd_barrier_post(unsigned* bar, volatile LAS unsigned* st) {
    XcdBarrier b; b.bar = bar; b.x = xb_xcc_id(); b.st = st;
    if (threadIdx.x == 0) (void)xb_add(&bar[XB_XCNT(b.x)], 1u);
    return b;
}
__device__ __forceinline__ void xcd_barrier_complete(unsigned* bar, unsigned x, unsigned& nloc, unsigned& nx) {
    const unsigned G = gridDim.x * gridDim.y * gridDim.z;
    unsigned sum, cnt, mine, sp = 0u;
    for (;;) {
        sum = 0u; cnt = 0u; mine = 0u;
#pragma unroll
        for (unsigned j = 0; j < 16; ++j) { const unsigned c = xb_ld(&bar[XB_XCNT(j)]); sum += c; cnt += (c > 0u) ? 1u : 0u; mine = (j == x) ? c : mine; }
        if (sum == G) break;
        __builtin_amdgcn_s_sleep(1);
        if ((++sp & 255u) == 0u) { if (xb_ld(&bar[XB_TMO])) break; if (sp > XB_SPIN_CAP) { atomicAdd(&bar[XB_TMO], 1u); break; } }
    }
    nloc = mine > 0u ? mine : 1u; nx = cnt > 0u ? cnt : 1u;
}

__device__ __forceinline__ void xcd_barrier(const XcdBarrier& b) {
    asm volatile("s_waitcnt vmcnt(0)" ::: "memory");
    __syncthreads();
    if (threadIdx.x == 0) {
        unsigned* bar = b.bar;
        __builtin_amdgcn_s_waitcnt(0);
        unsigned nloc = b.st[0], nx = b.st[1];
        if (nloc == 0u) { xcd_barrier_complete(bar, b.x, nloc, nx); b.st[0] = nloc; b.st[1] = nx; }
        const unsigned old = xb_add(&bar[XB_XSUB(b.x)], 1u);
        const unsigned gen = old / nloc;
        if (old + 1u == (gen + 1u) * nloc) {
            __builtin_amdgcn_fence(__ATOMIC_RELEASE, "agent");
            asm volatile("s_waitcnt vmcnt(0)" ::: "memory");
            const unsigned og = xb_add(&bar[XB_TOP], 1u);
            const unsigned tg = og / nx;
            if (og + 1u == (tg + 1u) * nx) xb_add(&bar[XB_TOPGEN], 1u);
            else XB_SPIN(xb_ld(&bar[XB_TOPGEN]) == tg, bar);
            __builtin_amdgcn_fence(__ATOMIC_ACQUIRE, "agent");
            xb_add(&bar[XB_XGEN(b.x)], 1u);
            asm volatile("s_waitcnt vmcnt(0)" ::: "memory");
        } else {
            XB_SPIN(xb_ld(&bar[XB_XGEN(b.x)]) == gen, bar);
            __builtin_amdgcn_fence(__ATOMIC_ACQUIRE, "agent");
            asm volatile("s_waitcnt vmcnt(0)" ::: "memory");
        }
    }
    __syncthreads();
}

__global__ void __launch_bounds__(512, 2) hybrid_fwd(Args a) {
    extern __shared__ __attribute__((aligned(16))) unsigned char lds_raw[];
    LAS unsigned char* lds = (LAS unsigned char*)lds_raw;
    cg::grid_group grid = cg::this_grid();
    { volatile LAS unsigned* st0 = (volatile LAS unsigned*)(lds + 140000); if (threadIdx.x < 2) st0[threadIdx.x] = 0u; __syncthreads(); }
    const XcdBarrier xbar = xcd_barrier_post((unsigned*)(a.ws + WS_CTL + 524288), (volatile LAS unsigned*)(lds + 140000));
#define GSYNC() xcd_barrier(xbar)
    unsigned char* ws = a.ws;
    float* COND = (float*)(ws + WS_CTL + CT_COND); float* ROWSS = (float*)(ws + WS_RSP); float* LBT = (float*)(ws + WS_CTL + CT_LBT);
    bf16_t* WINT = (bf16_t*)(ws + WS_WIN); bf16_t* WOUTT = (bf16_t*)(ws + WS_WOUT); bf16_t* W1T = (bf16_t*)(ws + WS_W1); bf16_t* W2T = (bf16_t*)(ws + WS_W2);
    bf16_t* ABUF = (bf16_t*)(ws + WS_ABUF);
    bf16_t* QH = (bf16_t*)(ws + WS_QH); bf16_t* LF = (bf16_t*)(ws + WS_LF); bf16_t* VH = (bf16_t*)(ws + WS_VH); bf16_t* GH = (bf16_t*)(ws + WS_GH);
    bf16_t* AQ = (bf16_t*)(ws + WS_AQ); bf16_t* AK = (bf16_t*)(ws + WS_AK); bf16_t* VT = (bf16_t*)(ws + WS_VT);
    bf16_t* ST = (bf16_t*)(ws + WS_ST); float* GG = (float*)(ws + WS_G);
    unsigned* DIAGW = (unsigned*)(ws + WS_CTL + 500000); (void)DIAGW;
    bf16_t* YRAW1 = (bf16_t*)(ws + WS_YRAW1); bf16_t* UB = (bf16_t*)(ws + WS_U); bf16_t* YRAW2 = (bf16_t*)(ws + WS_YRAW2);

    {
        const int tid = otid(), lane = tid & 63, wave = tid >> 6;
        LAS float* sc = (LAS float*)lds;
        LAS float* part = (LAS float*)(lds + 32768);
        if ((int)blockIdx.x < 192) {
            for (int i = tid; i < 8 * D; i += 512) sc[i] = siluf(a.c[i]);
            __syncthreads();
        }
        for (int ib = blockIdx.x; ib < 192; ib += gridDim.x) {
            const int col = tid & 31, kg = tid >> 5, j = ib * 32 + col;
            float ac[8];
#pragma unroll
            for (int b = 0; b < 8; ++b) ac[b] = 0.f;
#pragma unroll 8
            for (int kk = 0; kk < 64; ++kk) { const int k = kg * 64 + kk; const float w = a.w_ada[(size_t)k * NMOD6 + j];
#pragma unroll
                for (int b = 0; b < 8; ++b) ac[b] += sc[b * D + k] * w; }
#pragma unroll
            for (int b = 0; b < 8; ++b) part[(kg * 8 + b) * 32 + col] = ac[b];
            __syncthreads();
            if (tid < 256) { const int b = tid >> 5; float t = 0.f;
#pragma unroll
                for (int g = 0; g < 16; ++g) t += part[(g * 8 + b) * 32 + col];
                COND[b * NMOD6 + ib * 32 + col] = t; }
            __syncthreads();
        }
        if (blockIdx.x == gridDim.x - 1) { const float l0 = a.lb_logits[tid], l1 = a.lb_logits[HGW + tid]; LBT[tid] = 0.f; LBT[HGW + tid] = 1.f / (1.f + __expf(l0 - l1)); }
        LAS float* scr = (LAS float*)(lds + 49152 + wave * 8448);
        const int gw = blockIdx.x * 8 + wave, NGW = gridDim.x * 8;
        constexpr int I_IN = (D / 64) * (INC / 32), I_OUT = (D / 64) * (D / 32), I_1 = (D / 64) * (FF / 32), I_2 = (FF / 64) * (D / 32), I_L = I_IN + I_OUT + I_1 + I_2;
        for (int it = gw; it < 2 * I_L; it += NGW) {
            const int l = it / I_L; int r = it % I_L;
            if (r < I_IN) { transpose_item(a.w_in + (size_t)l * D * INC, D, INC, WINT + (size_t)l * INC * D, scr, r, lane); continue; } r -= I_IN;
            if (r < I_OUT) { transpose_item(a.w_out + (size_t)l * D * D, D, D, WOUTT + (size_t)l * D * D, scr, r, lane); continue; } r -= I_OUT;
            if (r < I_1) { transpose_item(a.w_ff1 + (size_t)l * D * FF, D, FF, W1T + (size_t)l * FF * D, scr, r, lane); continue; } r -= I_1;
            transpose_item(a.w_ff2 + (size_t)l * FF * D, FF, D, W2T + (size_t)l * D * FF, scr, r, lane);
        }
    }
    grid.sync();

    row_phase(a.x, nullptr, nullptr, nullptr, nullptr, COND, nullptr, 0, ABUF, a.pre_mix, a.ada_bias, 0, 1);
    GSYNC();
    { const int l = 0; STOPK(1, ABUF) }
    DCHK_BF(ABUF, (size_t)M * D, 0); DCHK_BF(WINT, (size_t)2 * INC * D, 1); DCHK_BF(W1T, (size_t)2 * FF * D, 1); DCHK_BF(W2T, (size_t)2 * FF * D, 1); DCHK_BF(WOUTT, (size_t)2 * D * D, 1);
#pragma unroll 1
    for (int l = 0; l < 2; ++l) {
        const float* biasl = a.ada_bias + (size_t)l * NMOD6;
        STOPK(11, ABUF)
        { pg8::Gemm g{ABUF, WINT + (size_t)l * INC * D, M, INC, D}; pg8::StaticOrder S; S.init(M, INC, (int)gridDim.x, (int)blockIdx.x);
          EpiIn E{QH, LF, VH, GH, AQ, AK, VT, LBT + l * HGW};
#ifndef SKIP_G1
#ifdef REP_GEMM
          pg8::gemm_phase<EpiIn, pg8::StaticOrder, true, true>(lds, g, S, E);
#endif
          pg8::gemm_phase<EpiIn, pg8::StaticOrder, true, true>(lds, g, S, E);
#endif
        }
        GSYNC();
        STOPK(2, LF) STOPK(12, QH) STOPK(13, AQ)
        DCHK_BF(QH, (size_t)M * HGW, 2 + 16 * l); DCHK_BF(LF, (size_t)2 * M * HGW, 3 + 16 * l); DCHK_BF(VH, (size_t)M * HGW, 4 + 16 * l); DCHK_BF(GH, (size_t)M * HGW, 4 + 16 * l); DCHK_BF(AQ, (size_t)M * HGW, 5 + 16 * l); DCHK_BF(AK, (size_t)M * 128, 5 + 16 * l); DCHK_BF(VT, (size_t)M * 128, 5 + 16 * l);
#ifdef REP_MIX
        attn_prep(AQ, AK, a.q_gain + l * 64, a.k_gain + l * 64);
#pragma unroll 1
        for (int rep = 0; rep < 2; ++rep) {
#define SKIP_PREP
#endif
#ifndef SKIP_H1
        h1_phase(lds, LF, VH, ST, GG);
#endif
#ifdef REP_H1
        h1_phase(lds, LF, VH, ST, GG);
#endif
#ifndef SKIP_PREP
        attn_prep(AQ, AK, a.q_gain + l * 64, a.k_gain + l * 64);
#endif
        GSYNC();
        STOPK(3, ST) STOPK(14, AQ)
        DCHK_BF(ST, (size_t)2048 * 128 * 128, 6 + 16 * l); DCHK_F(GG, (size_t)2048 * 128, 6 + 16 * l); DCHK_BF(AQ, (size_t)M * HGW, 7 + 16 * l); DCHK_BF(AK, (size_t)M * 128, 7 + 16 * l);
#ifndef SKIP_H2
        h2_phase(ST, GG);
#endif
#ifndef SKIP_ATT
        attn_phase(lds, AQ, AK, VT, ABUF, a.ao_gain + l * 64, ST, GG, a.q_gain + l * 64, a.k_gain + l * 64);
#endif
#ifdef REP_ATT
        attn_phase(lds, AQ, AK, VT, ABUF, a.ao_gain + l * 64, ST, GG, a.q_gain + l * 64, a.k_gain + l * 64);
#endif
        GSYNC();
        STOPK(4, ST) STOPK(15, ABUF)
        DCHK_BF(ST, (size_t)2048 * 128 * 128, 8 + 16 * l); DCHK_BF(ABUF, (size_t)M * D, 9 + 16 * l);
#ifndef SKIP_H3
        h3_phase(lds, LF, QH, VH, GH, ST, a.hg_gain + l * 128, ABUF);
#endif
#ifdef REP_H3
        h3_phase(lds, LF, QH, VH, GH, ST, a.hg_gain + l * 128, ABUF);
#endif
        GSYNC();
        STOPK(5, ABUF)
        DCHK_BF(ABUF, (size_t)M * D, 10 + 16 * l);
#ifdef REP_MIX
        }
#endif
        { pg8::Gemm g{ABUF, WOUTT + (size_t)l * D * D, M, D, D}; pg8::StaticOrder S; S.init(M, D, (int)gridDim.x, (int)blockIdx.x);
          EpiRaw E{YRAW1, ROWSS};
#ifndef SKIP_G2
#ifdef REP_GEMM
          pg8::gemm_phase<EpiRaw, pg8::StaticOrder, true, true>(lds, g, S, E);
#endif
          pg8::gemm_phase<EpiRaw, pg8::StaticOrder, true, true>(lds, g, S, E);
#endif
        }
        GSYNC();
        STOPK(6, YRAW1)
        DCHK_BF(YRAW1, (size_t)M * D, 11 + 16 * l);
        row_phase(l == 0 ? a.x : a.out, a.out, YRAW1, ROWSS, a.post_mix + l * D, COND, biasl, 2, ABUF, a.pre_ff + l * D, biasl, 3, 4);
        GSYNC();
        if (a.stop_at == 7 && l == a.stop_l) return;
        DCHK_F(a.out, (size_t)M * D, 12 + 16 * l); DCHK_BF(ABUF, (size_t)M * D, 12 + 16 * l);
        { pg8::Gemm g{ABUF, W1T + (size_t)l * FF * D, M, FF, D}; pg8::StaticOrder S; S.init(M, FF, (int)gridDim.x, (int)blockIdx.x);
          EpiRelu2 E{UB};
#ifndef SKIP_G3
#ifdef REP_GEMM
          pg8::gemm_phase<EpiRelu2, pg8::StaticOrder, true, true>(lds, g, S, E);
#endif
          pg8::gemm_phase<EpiRelu2, pg8::StaticOrder, true, true>(lds, g, S, E);
#endif
        }
        GSYNC();
        STOPK(8, UB)
        DCHK_BF(UB, (size_t)M * FF, 13 + 16 * l);
        { pg8::Gemm g{UB, W2T + (size_t)l * D * FF, M, D, FF}; pg8::StaticOrder S; S.init(M, D, (int)gridDim.x, (int)blockIdx.x);
          EpiRaw E{YRAW2, ROWSS};
#ifndef SKIP_G4
#ifdef REP_GEMM
          pg8::gemm_phase<EpiRaw, pg8::StaticOrder, true, true>(lds, g, S, E);
#endif
          pg8::gemm_phase<EpiRaw, pg8::StaticOrder, true, true>(lds, g, S, E);
#endif
        }
        GSYNC();
        STOPK(9, YRAW2)
        DCHK_BF(YRAW2, (size_t)M * D, 14 + 16 * l);
#ifdef HDEBUG
        row_phase<true>
#else
        row_phase<false>
#endif
            (a.out, a.out, YRAW2, ROWSS, a.post_ff + l * D, COND, biasl, 5, l == 0 ? ABUF : nullptr, a.pre_mix + D, a.ada_bias + NMOD6, 0, 1);
        if (a.stop_at == 10 && l == a.stop_l) return;
        if (l == 0) GSYNC();
    }
#ifdef DIAG
    GSYNC();
    DCHK_F(a.out, (size_t)M * D, 31);
    GSYNC();
    { int first = -1; for (int k = 0; k < 32; ++k) if (first < 0 && DIAGW[k]) first = k;
      if (first >= 0) { const size_t gt = (size_t)blockIdx.x * 512 + otid(), GN = (size_t)gridDim.x * 512;
          for (size_t i = gt; i < (size_t)M * D; i += GN) a.out[i] = (i == 0) ? 1000.f * (float)(first + 1) : 0.f; } }
#endif
}

extern "C" void kernel_launch(void* const* d_in, const int* in_sizes, int n_in, void* d_out, int out_size, void* d_ws, size_t ws_size, hipStream_t stream) {
    static int grid = 0;
    if (grid == 0) {
        if (n_in != 17 || in_sizes[0] != M * D || out_size != M * D || ws_size < WS_END) { fprintf(stderr, "kernel_launch: unexpected shapes (n_in %d, in0 %d, out %d, ws %zu)\n", n_in, n_in > 0 ? in_sizes[0] : -1, out_size, ws_size); grid = -1; return; }
        int dev = 0, cus = 0, per_cu = 0;
        if (hipGetDevice(&dev) != hipSuccess || hipDeviceGetAttribute(&cus, hipDeviceAttributeMultiprocessorCount, dev) != hipSuccess) { grid = -1; return; }
        if (hipFuncSetAttribute((const void*)hybrid_fwd, hipFuncAttributeMaxDynamicSharedMemorySize, LDS_BYTES) != hipSuccess) { fprintf(stderr, "hipFuncSetAttribute failed\n"); grid = -1; return; }
        if (hipOccupancyMaxActiveBlocksPerMultiprocessor(&per_cu, (const void*)hybrid_fwd, 512, LDS_BYTES) != hipSuccess || per_cu < 1) { fprintf(stderr, "occupancy query: %d\n", per_cu); (void)hipGetLastError(); per_cu = 1; }
        grid = cus * 1;
    }
    if (grid < 0) return;
    if (hipMemsetAsync((char*)d_ws + WS_CTL + 524288, 0, 16384, stream) != hipSuccess) { fprintf(stderr, "memset failed\n"); return; }
    Args a{};
    a.x = (const float*)d_in[0]; a.c = (const float*)d_in[1]; a.w_ada = (const float*)d_in[2]; a.ada_bias = (const float*)d_in[3]; a.lb_logits = (const float*)d_in[4];
    a.pre_mix = (const float*)d_in[5]; a.post_mix = (const float*)d_in[6]; a.w_in = (const float*)d_in[7]; a.w_out = (const float*)d_in[8]; a.hg_gain = (const float*)d_in[9];
    a.q_gain = (const float*)d_in[10]; a.k_gain = (const float*)d_in[11]; a.ao_gain = (const float*)d_in[12]; a.pre_ff = (const float*)d_in[13]; a.post_ff = (const float*)d_in[14];
    a.w_ff1 = (const float*)d_in[15]; a.w_ff2 = (const float*)d_in[16];
    a.out = (float*)d_out; a.ws = (unsigned char*)d_ws; a.stop_at = STOP_AT; a.stop_l = STOP_L;
    void* args[] = {&a};
    hipError_t e = hipLaunchCooperativeKernel((const void*)hybrid_fwd, dim3(grid), dim3(512), args, LDS_BYTES, stream);
    if (e != hipSuccess) fprintf(stderr, "cooperative launch failed: %s (grid %d)\n", hipGetErrorString(e), grid);
}
```
